# Optimizing an MI355X kernel written in HIP

```python
import math
import jax, jax.numpy as jnp
from jax import lax
import numpy as np

D_MODEL = 1024
BATCH = 16
SEQ = 256
DEPTH = 2
DEC_BATCH = 2
DEC_SEQ = 4096
PAST_LEN = 256

GRID_W = 64
HEAD_DIM = 64
A_HEADS = 6
A_KV = 2
B_HEADS = 6
B_KV = 2
C_HEADS = 4
C_QK_DIM = 32
C_V_DIM = 2 * C_QK_DIM
WINDOW = 128
Q_BLOCK = 128
ROPE_THETA = 10000.0
D_FF = 2816
CONV_W = 3
EPS = 1e-6
NEG_INF = -1e30
IN_SIZES = (A_HEADS * HEAD_DIM, A_KV * HEAD_DIM, A_KV * HEAD_DIM,
            B_HEADS * HEAD_DIM, B_KV * HEAD_DIM, B_KV * HEAD_DIM,
            C_HEADS * 2 * C_QK_DIM, C_HEADS * 2 * C_QK_DIM, C_HEADS * C_V_DIM)
D_IN = 2048
MIX_WIDTH = A_HEADS * HEAD_DIM + B_HEADS * HEAD_DIM + C_HEADS * C_V_DIM

kernel_name = 'hybrid_diffusion_prefix_step'


def rms_norm(x, g):
    xf = x.astype(jnp.float32)
    y = xf * lax.rsqrt(jnp.mean(xf * xf, axis=-1, keepdims=True) + EPS)
    return (y * g.astype(jnp.float32)).astype(x.dtype)


def modulation(cond, w, b):
    m = jax.nn.silu(cond) @ w + b
    return jnp.split(m, 6, axis=-1)


def rope_1d(x, pos):
    half = x.shape[-1] // 2
    inv = ROPE_THETA ** (-jnp.arange(half, dtype=jnp.float32) / half)
    ang = pos.astype(jnp.float32)[:, None] * inv[None, :]
    shape = (1, pos.shape[0]) + (1,) * (x.ndim - 3) + (half,)
    cos = jnp.cos(ang).reshape(shape)
    sin = jnp.sin(ang).reshape(shape)
    xf = x.astype(jnp.float32)
    x1, x2 = xf[..., :half], xf[..., half:]
    return jnp.concatenate([x1 * cos - x2 * sin, x2 * cos + x1 * sin], axis=-1).astype(x.dtype)


def rope_2d(x, rows, cols):
    h = x.shape[-1] // 2
    return jnp.concatenate([rope_1d(x[..., :h], rows), rope_1d(x[..., h:], cols)], axis=-1)


def to_blocks(a):
    B, T = a.shape[0], a.shape[1]
    return a.reshape((B, T // Q_BLOCK, Q_BLOCK) + a.shape[2:]).swapaxes(0, 1)


def from_blocks(a):
    nb, B = a.shape[0], a.shape[1]
    return a.swapaxes(0, 1).reshape((B, nb * Q_BLOCK) + a.shape[3:])


def gqa_dense_blocks(q, k, v, sink=None):
    B, T, H, d = q.shape
    KV = k.shape[2]
    G = H // KV
    scale = d ** -0.5

    def block(qb):
        qg = qb.reshape(B, Q_BLOCK, KV, G, d)
        s = jnp.einsum('bqkgd,bskd->bkgqs', qg, k).astype(jnp.float32) * scale
        if sink is not None:
            sk = jnp.broadcast_to(sink.astype(jnp.float32).reshape(1, KV, G, 1, 1), s.shape[:-1] + (1,))
            p = jax.nn.softmax(jnp.concatenate([s, sk], axis=-1), axis=-1)[..., :-1]
        else:
            p = jax.nn.softmax(s, axis=-1)
        o = jnp.einsum('bkgqs,bskd->bqkgd', p.astype(v.dtype), v)
        return o.reshape(B, Q_BLOCK, H, d)

    return from_blocks(lax.map(block, to_blocks(q)))


def diff_dense_blocks(q1, q2, k1, k2, v, lam):
    scale = q1.shape[-1] ** -0.5

    def block(qs):
        q1b, q2b = qs
        p1 = jax.nn.softmax(jnp.einsum('bqhd,bshd->bhqs', q1b, k1).astype(jnp.float32) * scale, axis=-1)
        p2 = jax.nn.softmax(jnp.einsum('bqhd,bshd->bhqs', q2b, k2).astype(jnp.float32) * scale, axis=-1)
        p = p1 - lam * p2
        return jnp.einsum('bhqs,bshe->bqhe', p.astype(v.dtype), v)

    return from_blocks(lax.map(block, (to_blocks(q1), to_blocks(q2))))


def window_attn_latent(q, k, v, k_ctx, v_ctx, sink):
    B, T, H, d = q.shape
    KV = k.shape[2]
    G = H // KV
    nb = T // Q_BLOCK
    scale = d ** -0.5
    pad = ((0, 0), (WINDOW, WINDOW), (0, 0), (0, 0))
    kp = jnp.pad(k, pad).reshape(B, nb + 2, Q_BLOCK, KV, d)
    vp = jnp.pad(v, pad).reshape(B, nb + 2, Q_BLOCK, KV, d)
    k_band = jnp.concatenate([kp[:, :-2], kp[:, 1:-1], kp[:, 2:]], axis=2)
    v_band = jnp.concatenate([vp[:, :-2], vp[:, 1:-1], vp[:, 2:]], axis=2)
    qg = q.reshape(B, nb, Q_BLOCK, KV, G, d)
    s_band = jnp.einsum('bnqkgd,bnskd->bnkgqs', qg, k_band).astype(jnp.float32) * scale
    qi = jnp.arange(Q_BLOCK)[:, None]
    sj = jnp.arange(3 * Q_BLOCK)[None, :]
    rel = sj - qi - Q_BLOCK
    kpos = jnp.arange(nb)[:, None, None] * Q_BLOCK - Q_BLOCK + sj[None]
    allowed = (jnp.abs(rel) <= WINDOW)[None] & (kpos >= 0) & (kpos < T)
    s_band = jnp.where(allowed[None, :, None, None], s_band, NEG_INF)
    s_ctx = jnp.einsum('bnqkgd,bskd->bnkgqs', qg, k_ctx).astype(jnp.float32) * scale
    sk = jnp.broadcast_to(sink.astype(jnp.float32).reshape(1, 1, KV, G, 1, 1), s_band.shape[:-1] + (1,))
    p = jax.nn.softmax(jnp.concatenate([s_band, s_ctx, sk], axis=-1), axis=-1)
    n_band = 3 * Q_BLOCK
    n_ctx = k_ctx.shape[1]
    o = (jnp.einsum('bnkgqs,bnskd->bnqkgd', p[..., :n_band].astype(v.dtype), v_band)
         + jnp.einsum('bnkgqs,bskd->bnqkgd', p[..., n_band:n_band + n_ctx].astype(v.dtype), v_ctx))
    return o.reshape(B, T, H, d)


def project(h, w_in):
    z = h @ w_in
    B, T = z.shape[0], z.shape[1]
    parts = jnp.split(z, np.cumsum(IN_SIZES)[:-1].tolist(), axis=-1)
    shapes = ((A_HEADS, HEAD_DIM), (A_KV, HEAD_DIM), (A_KV, HEAD_DIM),
              (B_HEADS, HEAD_DIM), (B_KV, HEAD_DIM), (B_KV, HEAD_DIM),
              (C_HEADS, 2, C_QK_DIM), (C_HEADS, 2, C_QK_DIM), (C_HEADS, C_V_DIM))
    return tuple(p.reshape((B, T) + s) for p, s in zip(parts, shapes))


def diff_lambda(lq1, lk1, lq2, lk2, lam_init):
    f = lambda a, b: jnp.exp(jnp.sum(a.astype(jnp.float32) * b.astype(jnp.float32)))
    return f(lq1, lk1) - f(lq2, lk2) + lam_init


def merge_out(oa, ob, oc, g_sub, lam_init, w_out):
    B, T = oa.shape[0], oa.shape[1]
    oc = rms_norm(oc, g_sub) * (1.0 - lam_init)
    o = jnp.concatenate([oa.reshape(B, T, -1), ob.reshape(B, T, -1), oc.reshape(B, T, -1)], axis=-1)
    return o @ w_out


def conv_ffn(h, w_up, conv_w, conv_b, w_down):
    u = h @ w_up
    up = jnp.pad(u, ((0, 0), (1, 1), (0, 0)))
    u = conv_w[0] * up[:, :-2] + conv_w[1] * up[:, 1:-1] + conv_w[2] * up[:, 2:] + conv_b
    a, g = jnp.split(u, 2, axis=-1)
    return (jax.nn.silu(a) * g) @ w_down


def setup_inputs(seed: int = 0) -> dict:
    key = jax.random.key(seed)
    ks = jax.random.split(key, 30)

    def nrm(k, shape, s=1.0):
        return jax.random.normal(k, shape, jnp.float32) * s

    def gain(k, shape):
        return 1.0 + nrm(k, shape, 0.05)

    return {
        'x_prompt': nrm(ks[0], (BATCH, SEQ, D_MODEL)),
        'x_sample': nrm(ks[1], (DEC_BATCH, DEC_SEQ, D_MODEL)),
        'cache_a_k': nrm(ks[2], (DEC_BATCH, DEPTH, PAST_LEN, A_KV, HEAD_DIM)),
        'cache_a_v': nrm(ks[3], (DEC_BATCH, DEPTH, PAST_LEN, A_KV, HEAD_DIM)),
        'cache_b_k': nrm(ks[4], (DEC_BATCH, DEPTH, PAST_LEN, B_KV, HEAD_DIM)),
        'cache_b_v': nrm(ks[5], (DEC_BATCH, DEPTH, PAST_LEN, B_KV, HEAD_DIM)),
        'cache_c_k': nrm(ks[6], (DEC_BATCH, DEPTH, PAST_LEN, C_HEADS, 2 * C_QK_DIM)),
        'cache_c_v': nrm(ks[7], (DEC_BATCH, DEPTH, PAST_LEN, C_HEADS, C_V_DIM)),
        'c': nrm(ks[8], (DEC_BATCH, D_MODEL)),
        'c_ctx': nrm(ks[9], (D_MODEL,)),
        'w_ada': nrm(ks[10], (DEPTH, D_MODEL, 6 * D_MODEL), D_MODEL ** -0.5),
        'b_ada': nrm(ks[11], (DEPTH, 6 * D_MODEL), 0.02),
        'g_norm1': gain(ks[12], (DEPTH, D_MODEL)),
        'g_norm2': gain(ks[13], (DEPTH, D_MODEL)),
        'w_in': nrm(ks[14], (DEPTH, D_MODEL, D_IN), D_MODEL ** -0.5),
        'g_qa': gain(ks[15], (DEPTH, HEAD_DIM)),
        'g_ka': gain(ks[16], (DEPTH, HEAD_DIM)),
        'sink_b': nrm(ks[17], (DEPTH, B_HEADS), 0.5),
        'lam_q1': nrm(ks[18], (DEPTH, C_QK_DIM), 0.1),
        'lam_k1': nrm(ks[19], (DEPTH, C_QK_DIM), 0.1),
        'lam_q2': nrm(ks[20], (DEPTH, C_QK_DIM), 0.1),
        'lam_k2': nrm(ks[21], (DEPTH, C_QK_DIM), 0.1),
        'g_subln': gain(ks[22], (DEPTH, C_V_DIM)),
        'w_out': nrm(ks[23], (DEPTH, MIX_WIDTH, D_MODEL), MIX_WIDTH ** -0.5),
        'w_up': nrm(ks[24], (DEPTH, D_MODEL, 2 * D_FF), D_MODEL ** -0.5),
        'conv_w': nrm(ks[25], (DEPTH, CONV_W, 2 * D_FF), CONV_W ** -0.5),
        'conv_b': nrm(ks[26], (DEPTH, 2 * D_FF), 0.02),
        'w_down': nrm(ks[27], (DEPTH, D_FF, D_MODEL), D_FF ** -0.5),
        'g_final': gain(ks[28], (D_MODEL,)),
    }


def reference(x_prompt, x_sample, cache_a_k, cache_a_v, cache_b_k, cache_b_v, cache_c_k, cache_c_v,
              c, c_ctx, w_ada, b_ada, g_norm1, g_norm2, w_in, g_qa, g_ka, sink_b,
              lam_q1, lam_k1, lam_q2, lam_k2, g_subln, w_out, w_up, conv_w, conv_b, w_down, g_final):
    x = x_prompt
    Bp, Tp = x.shape[0], x.shape[1]
    cond = c_ctx[None, None, :]
    ak_l, av_l, bk_l, bv_l, ck_l, cv_l = [], [], [], [], [], []
    for l in range(DEPTH):
        lam_init = 0.8 - 0.6 * math.exp(-0.3 * l)
        sh1, sc1, gt1, sh2, sc2, gt2 = modulation(cond, w_ada[l], b_ada[l])
        h = rms_norm(x, g_norm1[l]) * (1 + sc1) + sh1
        qa, ka, va, qb, kb, vb, qc, kc, vc = project(h, w_in[l])
        qa = rms_norm(qa, g_qa[l])
        ka = rms_norm(ka, g_ka[l])
        lam = diff_lambda(lam_q1[l], lam_k1[l], lam_q2[l], lam_k2[l], lam_init)
        oa = gqa_dense_blocks(qa, ka, va)
        ob = gqa_dense_blocks(qb, kb, vb, sink_b[l])
        oc = diff_dense_blocks(qc[..., 0, :], qc[..., 1, :], kc[..., 0, :], kc[..., 1, :], vc, lam)
        x = x + gt1 * merge_out(oa, ob, oc, g_subln[l], lam_init, w_out[l])
        h = rms_norm(x, g_norm2[l]) * (1 + sc2) + sh2
        x = x + gt2 * conv_ffn(h, w_up[l], conv_w[l], conv_b[l], w_down[l])
        ak_l.append(ka)
        av_l.append(va)
        bk_l.append(kb)
        bv_l.append(vb)
        ck_l.append(kc.reshape(Bp, Tp, C_HEADS, 2 * C_QK_DIM))
        cv_l.append(vc)
    y_prompt = rms_norm(x, g_final)
    new_a_k = jnp.stack(ak_l, axis=1)
    new_a_v = jnp.stack(av_l, axis=1)
    new_b_k = jnp.stack(bk_l, axis=1)
    new_b_v = jnp.stack(bv_l, axis=1)
    new_c_k = jnp.stack(ck_l, axis=1)
    new_c_v = jnp.stack(cv_l, axis=1)

    x = x_sample
    Bs, Ts = x.shape[0], x.shape[1]
    P = cache_c_k.shape[2]
    t = jnp.arange(Ts)
    rows = t // GRID_W
    cols = t % GRID_W
    cond = c[:, None, :]
    for l in range(DEPTH):
        lam_init = 0.8 - 0.6 * math.exp(-0.3 * l)
        sh1, sc1, gt1, sh2, sc2, gt2 = modulation(cond, w_ada[l], b_ada[l])
        h = rms_norm(x, g_norm1[l]) * (1 + sc1) + sh1
        qa, ka, va, qb, kb, vb, qc, kc, vc = project(h, w_in[l])
        qa = rope_2d(rms_norm(qa, g_qa[l]), rows, cols)
        ka = rope_2d(rms_norm(ka, g_ka[l]), rows, cols)
        qb = rope_2d(qb, rows, cols)
        kb = rope_2d(kb, rows, cols)
        qc = rope_2d(qc, rows, cols)
        kc = rope_2d(kc, rows, cols)
        lam = diff_lambda(lam_q1[l], lam_k1[l], lam_q2[l], lam_k2[l], lam_init)
        ak = jnp.concatenate([cache_a_k[:, l], ka], axis=1)
        av = jnp.concatenate([cache_a_v[:, l], va], axis=1)
        oa = gqa_dense_blocks(qa, ak, av)
        ob = window_attn_latent(qb, kb, vb, cache_b_k[:, l], cache_b_v[:, l], sink_b[l])
        kc_all = jnp.concatenate([cache_c_k[:, l].reshape(Bs, P, C_HEADS, 2, C_QK_DIM), kc], axis=1)
        vc_all = jnp.concatenate([cache_c_v[:, l], vc], axis=1)
        oc = diff_dense_blocks(qc[..., 0, :], qc[..., 1, :], kc_all[..., 0, :], kc_all[..., 1, :], vc_all, lam)
        x = x + gt1 * merge_out(oa, ob, oc, g_subln[l], lam_init, w_out[l])
        h = rms_norm(x, g_norm2[l]) * (1 + sc2) + sh2
        x = x + gt2 * conv_ffn(h, w_up[l], conv_w[l], conv_b[l], w_down[l])
    y_sample = rms_norm(x, g_final)

    return (y_prompt, y_sample, new_a_k, new_a_v, new_b_k, new_b_v, new_c_k, new_c_v)
```

```cpp
#ifndef MK_N_LAUNCHES
#define MK_N_LAUNCHES 0
#endif
#include <hip/hip_runtime.h>
#include <cstdio>
#include <cstdint>
namespace pg8 {
#define PG8_LAS __attribute__((address_space(3)))
typedef unsigned short bf16_t;
typedef short bf16x8 __attribute__((ext_vector_type(8)));
typedef float f32x4 __attribute__((ext_vector_type(4)));
typedef unsigned u32x4 __attribute__((ext_vector_type(4)));
constexpr int BM = 256, BK = 64, HALF = 128, HTB = HALF * BK * 2  , STAGE_BYTES = 8 * HTB, NXCD = 8, WGM = 8;

__host__ __device__ __forceinline__ int lds_byte(int r, int c) { const int st = (r >> 4) * 2 + (c >> 5), rr = r & 15, cc = c & 31, ob = rr * 64 + cc * 2; return st * 1024 + (ob ^ (((ob >> 9) & 1) << 5)); }
__host__ __device__ __forceinline__ void stage_rc(int b, int& R, int& C) { const int st = b / 1024, sb = b % 1024, swz = sb ^ (((sb >> 9) & 1) << 5); R = (st >> 1) * 16 + swz / 64; C = (st & 1) * 32 + (swz % 64) / 2; }
__host__ __device__ __forceinline__ int perm32(int rho) { const int n = rho >> 4, i = rho & 15; return 8 * (i >> 2) + 4 * n + (i & 3); }

struct Unit { int pm, pn; };
struct Gemm { const bf16_t* A; const bf16_t* Bt; int M, N, K; };

struct StaticOrder {
    int nM, nN, nwg, G, c;
    __host__ __device__ void init(int M, int N, int G_, int c_) { nM = M / BM; nN = N / BM; nwg = nM * nN; G = G_; c = c_; }
    __host__ __device__ bool next(int i, Unit& u) const {
        const long L = (long)i * G + c; if (L >= nwg) return false;
        int wgid = (int)L; { const int q = nwg / NXCD, r = nwg % NXCD, xcd = wgid % NXCD, off = wgid / NXCD; wgid = (xcd < r ? xcd * (q + 1) : r * (q + 1) + (xcd - r) * q) + off; }
        const int nig = WGM * nN, gid = wgid / nig, fm = gid * WGM, gsz = (nM - fm) < WGM ? (nM - fm) : WGM;
        u.pm = fm + ((wgid % nig) % gsz); u.pn = (wgid % nig) / gsz; return true;
    }
    __device__ __forceinline__ void a_ready(const Unit&) const {}
    __device__ __forceinline__ void done(const Unit&) const {}
};
__device__ __forceinline__ unsigned cvt_pk_bf16(float lo, float hi) { unsigned r; asm volatile("v_cvt_pk_bf16_f32 %0, %1, %2" : "=v"(r) : "v"(lo), "v"(hi)); return r; }
typedef unsigned u32x2 __attribute__((ext_vector_type(2)));
constexpr float RMS_EPS = 1e-6f, LOG2E = 1.4426950408889634f;
constexpr float C2_64 = 0.125f * LOG2E, C2_32 = 0.17677669529663687f * LOG2E;
constexpr int NTOK = 12288, NPROMPT = 4096;
constexpr long KA_S = 0, VA_S = 1114112, KB_S = 2228224, VB_S = 3342336, KC_S = 4456448, VC_S = 6684672,
               KA_P = 8912896, VA_P = 9437184, KB_P = 9961472, VB_P = 10485760, KC_P = 11010048, VC_P = 12058624, KV_ELEMS = 13107200;
constexpr long O_NAK = 12582912, O_NAV = 13631488, O_NBK = 14680064, O_NBV = 15728640, O_NCK = 16777216, O_NCV = 18874368, O_TOTAL = 20971520;

struct EpiIn {
    static constexpr bool PERM = false, AFTER_DRAIN = false;
    int layer; const float* sumsq; const float* cin; const float* gqa; const float* gka; const float* rope; bf16_t* Q; bf16_t* KV; float* out;
    __device__ __forceinline__ void operator()(const f32x4 (&acc)[2][2][4][2], const Unit& u, int wr, int wc, int fr, int fq) const {
        const int g = u.pn * 4 + wc;
        const bool smp = u.pm >= 16;
        const int sq = smp ? ((u.pm - 16) >> 4) : u.pm;
        const int t0 = smp ? ((u.pm - 16) & 15) * 256 : 0;
        const int cond = smp ? 1 + sq : 0;
        int mix, kind, hh;
        if (g < 6) { mix = 0; kind = 0; hh = g; } else if (g < 8) { mix = 0; kind = 1; hh = g - 6; } else if (g < 10) { mix = 0; kind = 2; hh = g - 8; }
        else if (g < 16) { mix = 1; kind = 0; hh = g - 10; } else if (g < 18) { mix = 1; kind = 1; hh = g - 16; } else if (g < 20) { mix = 1; kind = 2; hh = g - 18; }
        else if (g < 24) { mix = 2; kind = 0; hh = g - 20; } else if (g < 28) { mix = 2; kind = 1; hh = g - 24; } else { mix = 2; kind = 2; hh = g - 28; }
        const bool c32 = (mix == 2) && (kind != 2);
        const int nst = c32 ? 8 : 16;
        const int dlo = c32 ? (16 * (fq >> 1) + 4 * (fq & 1)) : 4 * fq;
        bf16_t* dst; long dpitch, drow0; float* fo = nullptr; long forow0 = 0;
        if (kind == 0) { dst = Q + (mix == 0 ? 0 : mix == 1 ? 384 : 768) + hh * 64; dpitch = 1024; drow0 = (long)u.pm * 256; }
        else {
            dpitch = (mix == 2) ? 256 : 128;
            long off;
            if (smp) { off = mix == 0 ? (kind == 1 ? KA_S : VA_S) : mix == 1 ? (kind == 1 ? KB_S : VB_S) : (kind == 1 ? KC_S : VC_S); drow0 = (long)sq * 4352 + 256 + t0; }
            else { off = mix == 0 ? (kind == 1 ? KA_P : VA_P) : mix == 1 ? (kind == 1 ? KB_P : VB_P) : (kind == 1 ? KC_P : VC_P); drow0 = (long)sq * 256;
                   fo = out + (mix == 0 ? (kind == 1 ? O_NAK : O_NAV) : mix == 1 ? (kind == 1 ? O_NBK : O_NBV) : (kind == 1 ? O_NCK : O_NCV)) + hh * 64; forow0 = ((long)sq * 2 + layer) * 256; }
            dst = KV + off + hh * 64;
        }
        const bool nrm = (mix == 0) && (kind < 2);
        const bool rp = smp && (kind < 2);
        const float qs = (kind == 0) ? (mix == 2 ? C2_32 : C2_64) : 1.0f;
        f32x4 cv[2][2];
        const float* cp = cin + cond * 2048 + g * 64 + dlo;
        const float* gp = ((kind == 0) ? gqa : gka) + 4 * fq;
#pragma unroll
        for (int bj = 0; bj < 2; ++bj)
#pragma unroll
            for (int n = 0; n < 2; ++n) cv[bj][n] = *(const f32x4*)(cp + 32 * bj + nst * n);
        const float* ssp = sumsq + u.pm * BM + wr * 64 + fr;
        bf16_t* dstb = dst + (drow0 + wr * 64 + fr) * dpitch + dlo;
        float* fob = fo ? fo + (forow0 + wr * 64 + fr) * dpitch + dlo : nullptr;
        const float* rrow = c32 ? rope + 2048 + ((t0 >> 6) + wr) * 8 + 4 * (fq & 1) : rope + ((t0 >> 6) + wr) * 16 + 4 * fq;
        const float* rcol = c32 ? rope + 2048 + fr * 8 + 4 * (fq & 1) : rope + fr * 16 + 4 * fq;
        const int rst = c32 ? 8 : 16, sof = c32 ? 512 : 1024;
#pragma unroll
        for (int ai = 0; ai < 2; ++ai)
#pragma unroll
            for (int m = 0; m < 4; ++m) {
                const float rstd = rsqrtf(ssp[ai * HALF + m * 16] * (1.0f / 1024.0f) + RMS_EPS);
                f32x4 v[2][2];
#pragma unroll
                for (int bj = 0; bj < 2; ++bj)
#pragma unroll
                    for (int n = 0; n < 2; ++n) v[bj][n] = acc[ai][bj][m][n] * rstd + cv[bj][n];
                if (nrm) {
                    float ss = 0.f;
#pragma unroll
                    for (int bj = 0; bj < 2; ++bj)
#pragma unroll
                        for (int n = 0; n < 2; ++n) { const f32x4 x = v[bj][n]; ss += (x[0] * x[0] + x[1] * x[1]) + (x[2] * x[2] + x[3] * x[3]); }
                    ss += __shfl_xor(ss, 16); ss += __shfl_xor(ss, 32);
                    const float rn = rsqrtf(ss * (1.0f / 64.0f) + RMS_EPS);
#pragma unroll
                    for (int bj = 0; bj < 2; ++bj)
#pragma unroll
                        for (int n = 0; n < 2; ++n) v[bj][n] = v[bj][n] * rn * (*(const f32x4*)(gp + 32 * bj + 16 * n));
                }
                if (fo) {
#pragma unroll
                    for (int bj = 0; bj < 2; ++bj)
#pragma unroll
                        for (int n = 0; n < 2; ++n) *(f32x4*)(fob + (long)(ai * HALF + m * 16) * dpitch + 32 * bj + nst * n) = v[bj][n];
                }
                if (rp) {
#pragma unroll
                    for (int bj = 0; bj < 2; ++bj) {
                        const bool colpart = c32 ? (fq >> 1) != 0 : (bj != 0);
                        const float* cs = colpart ? rcol + m * 16 * rst : rrow + 2 * ai * rst;
                        const f32x4 c = *(const f32x4*)cs, sn = *(const f32x4*)(cs + sof);
                        const f32x4 x1 = v[bj][0], x2 = v[bj][1];
                        v[bj][0] = x1 * c - x2 * sn; v[bj][1] = x2 * c + x1 * sn;
                    }
                }
#pragma unroll
                for (int bj = 0; bj < 2; ++bj)
#pragma unroll
                    for (int n = 0; n < 2; ++n) { const f32x4 w = v[bj][n] * qs; u32x2 pk; pk.x = cvt_pk_bf16(w[0], w[1]); pk.y = cvt_pk_bf16(w[2], w[3]);
                        *(u32x2*)(dstb + (long)(ai * HALF + m * 16) * dpitch + 32 * bj + nst * n) = pk; }
                asm volatile("" ::: "memory");
            }
    }
};

struct EpiRes {
    static constexpr bool PERM = false, AFTER_DRAIN = false;
    const float* src_p; const float* src_s; float* X; const float* gate; const float* gn; const float* scn; bf16_t* H; float* sumsq;
    __device__ __forceinline__ void operator()(const f32x4 (&acc)[2][2][4][2], const Unit& u, int wr, int wc, int fr, int fq) const {
        const bool smp = u.pm >= 16; const int cond = smp ? 1 + ((u.pm - 16) >> 4) : 0;
        const float* src = smp ? src_s + ((long)u.pm * BM - NPROMPT) * 1024 : src_p + (long)u.pm * BM * 1024;
        float* xo = X + (long)u.pm * BM * 1024; bf16_t* ho = H ? H + (long)u.pm * BM * 1024 : nullptr;
        const int col0 = u.pn * BM + wc * 32 + 4 * fq;
        f32x4 gt[2][2], gm[2][2];
#pragma unroll
        for (int bj = 0; bj < 2; ++bj)
#pragma unroll
            for (int n = 0; n < 2; ++n) { const int c = col0 + bj * HALF + n * 16; gt[bj][n] = *(const f32x4*)(gate + cond * 6144 + c);
                gm[bj][n] = H ? *(const f32x4*)(gn + c) * (*(const f32x4*)(scn + cond * 6144 + c) + 1.0f) : (f32x4){0.f, 0.f, 0.f, 0.f}; }
#pragma unroll
        for (int ai = 0; ai < 2; ++ai)
#pragma unroll
            for (int m = 0; m < 4; ++m) {
                const int rloc = ai * HALF + wr * 64 + m * 16 + fr; float ss = 0.f;
#pragma unroll
                for (int bj = 0; bj < 2; ++bj)
#pragma unroll
                    for (int n = 0; n < 2; ++n) { const long off = (long)rloc * 1024 + col0 + bj * HALF + n * 16;
                        const f32x4 x1 = *(const f32x4*)(src + off) + gt[bj][n] * acc[ai][bj][m][n]; *(f32x4*)(xo + off) = x1;
                        ss += (x1[0] * x1[0] + x1[1] * x1[1]) + (x1[2] * x1[2] + x1[3] * x1[3]);
                        if (H) { const f32x4 w = x1 * gm[bj][n]; u32x2 pk; pk.x = cvt_pk_bf16(w[0], w[1]); pk.y = cvt_pk_bf16(w[2], w[3]); *(u32x2*)(ho + off) = pk; } }
                ss += __shfl_xor(ss, 16); ss += __shfl_xor(ss, 32);
                if (fq == 0) unsafeAtomicAdd(sumsq + u.pm * BM + rloc, ss);
            }
    }
};

struct EpiUp {
    static constexpr bool PERM = false, AFTER_DRAIN = false;
    const float* sumsq; const float* cup; bf16_t* U;
    __device__ __forceinline__ void operator()(const f32x4 (&acc)[2][2][4][2], const Unit& u, int wr, int wc, int fr, int fq) const {
        const bool smp = u.pm >= 16; const int cond = smp ? 1 + ((u.pm - 16) >> 4) : 0;
        const int col0 = u.pn * BM + wc * 32 + 8 * fq;
        f32x4 cv[2][2];
#pragma unroll
        for (int bj = 0; bj < 2; ++bj)
#pragma unroll
            for (int n = 0; n < 2; ++n) cv[bj][n] = *(const f32x4*)(cup + cond * 5632 + col0 + bj * HALF + 4 * n);
#pragma unroll
        for (int ai = 0; ai < 2; ++ai)
#pragma unroll
            for (int m = 0; m < 4; ++m) {
                const int rloc = ai * HALF + wr * 64 + m * 16 + fr; const long row = (long)u.pm * BM + rloc;
                const float rstd = rsqrtf(sumsq[row] * (1.0f / 1024.0f) + RMS_EPS);
#pragma unroll
                for (int bj = 0; bj < 2; ++bj) { const f32x4 v0 = acc[ai][bj][m][0] * rstd + cv[bj][0], v1 = acc[ai][bj][m][1] * rstd + cv[bj][1];
                    u32x4 w; w.x = cvt_pk_bf16(v0[0], v0[1]); w.y = cvt_pk_bf16(v0[2], v0[3]); w.z = cvt_pk_bf16(v1[0], v1[1]); w.w = cvt_pk_bf16(v1[2], v1[3]);
                    *(u32x4*)(U + row * 5632 + col0 + bj * HALF) = w; }
            }
    }
};

template <class Epi, class Sched, bool ALIGN_EPI = false, bool SP2 = false>
__device__ __forceinline__ void gemm_phase(PG8_LAS unsigned char* lds, const Gemm g, const Sched& S, const Epi& E) {
    int tid_ = threadIdx.x; asm volatile("" : "+v"(tid_));
    const int tid = tid_, wid = __builtin_amdgcn_readfirstlane(tid >> 6), lane = tid & 63, wr = wid >> 2, wc = wid & 3, fr = lane & 15, fq = lane >> 4;
    const int K = g.K, nt = K / BK;
    unsigned voffA[2], voffB[2];
#pragma unroll
    for (int i = 0; i < 2; ++i) { int R, C; stage_rc(tid * 16 + i * 8192, R, C); const int Rb = Epi::PERM ? ((R & ~31) + perm32(R & 31)) : R;
        voffA[i] = (unsigned)(R * K + C) * 2u; voffB[i] = (unsigned)(Rb * K + C) * 2u; }
    const size_t kstep = (size_t)(BK * 2);
    const size_t hstep = (size_t)HALF * K * 2;
    const size_t tstep = 2 * hstep;
    const unsigned ldsw = (unsigned)wid * 1024u;
    const int aoff = lds_byte(wr * 64 + fr, fq * 8), boff = lds_byte(wc * 32 + fr, fq * 8);
#define PG8_SA(b, h) (((b) * 2 + (h)) * HTB)
#define PG8_SB(b, h) ((4 + (b) * 2 + (h)) * HTB)
#define PG8_STAGE(bufoff, gbase, voff) do { _Pragma("unroll") for (int _i = 0; _i < 2; ++_i) \
        __builtin_amdgcn_global_load_lds((const unsigned*)((const char*)(gbase) + (voff)[_i]), (PG8_LAS unsigned*)(lds + (bufoff) + ldsw + _i * 8192), 16, 0, 0); } while (0)
#define PG8_LDA(dst, b, h) do { _Pragma("unroll") for (int m = 0; m < 4; ++m) _Pragma("unroll") for (int k = 0; k < 2; ++k) dst[m][k] = *(const PG8_LAS bf16x8*)(lds + PG8_SA(b, h) + aoff + m * 2048 + k * 1024); } while (0)
#define PG8_LDB(dst, b, h) do { _Pragma("unroll") for (int n = 0; n < 2; ++n) _Pragma("unroll") for (int k = 0; k < 2; ++k) dst[n][k] = *(const PG8_LAS bf16x8*)(lds + PG8_SB(b, h) + boff + n * 2048 + k * 1024); } while (0)
#define PG8_MMA(ai, bj, At, Bt) do { __builtin_amdgcn_s_setprio(1); _Pragma("unroll") for (int m = 0; m < 4; ++m) _Pragma("unroll") for (int n = 0; n < 2; ++n) _Pragma("unroll") for (int k = 0; k < 2; ++k) \
        acc[ai][bj][m][n] = __builtin_amdgcn_mfma_f32_16x16x32_bf16(Bt[n][k], At[m][k], acc[ai][bj][m][n], 0, 0, 0); __builtin_amdgcn_s_setprio(0); } while (0)
#define PG8_WAIT_V(n) asm volatile("s_waitcnt vmcnt(" #n ")" ::: "memory")
#define PG8_WAIT_L(n) asm volatile("s_waitcnt lgkmcnt(" #n ")" ::: "memory")
#define PG8_BAR __builtin_amdgcn_s_barrier()
#define PG8_SCHED __builtin_amdgcn_sched_barrier(0)
    Unit cur, nxt; int ui = 0;
    if (!S.next(0, cur)) return;
    f32x4 acc[2][2][4][2];
#pragma unroll
    for (int a = 0; a < 2; ++a)
#pragma unroll
        for (int b = 0; b < 2; ++b)
#pragma unroll
            for (int m = 0; m < 4; ++m)
#pragma unroll
                for (int n = 0; n < 2; ++n) acc[a][b][m][n] = (f32x4){0.f, 0.f, 0.f, 0.f};
    bf16x8 At[4][2], B0[2][2], B1[2][2];
    const char* cA = (const char*)g.A + (size_t)cur.pm * tstep; const char* cB = (const char*)g.Bt + (size_t)cur.pn * tstep;
    S.a_ready(cur);
    if constexpr (SP2) {
        PG8_STAGE(PG8_SB(0, 0), cB, voffB); PG8_STAGE(PG8_SB(0, 1), cB + hstep, voffB); PG8_STAGE(PG8_SA(0, 0), cA, voffA); PG8_STAGE(PG8_SA(0, 1), cA + hstep, voffA);
        if (wr == 1) PG8_BAR;
        PG8_WAIT_V(2); PG8_BAR;
        PG8_STAGE(PG8_SB(1, 0), cB + kstep, voffB); PG8_STAGE(PG8_SA(1, 0), cA + kstep, voffA); PG8_STAGE(PG8_SB(1, 1), cB + hstep + kstep, voffB);
        PG8_WAIT_V(6); PG8_BAR;
    } else {
        PG8_STAGE(PG8_SB(0, 0), cB, voffB); PG8_STAGE(PG8_SA(0, 0), cA, voffA); PG8_STAGE(PG8_SB(0, 1), cB + hstep, voffB); PG8_STAGE(PG8_SA(0, 1), cA + hstep, voffA);
        if (wr == 1) PG8_BAR;
        PG8_WAIT_V(4); PG8_BAR;
        PG8_STAGE(PG8_SB(1, 0), cB + kstep, voffB); PG8_STAGE(PG8_SA(1, 0), cA + kstep, voffA); PG8_STAGE(PG8_SB(1, 1), cB + hstep + kstep, voffB);
        PG8_WAIT_V(6); PG8_BAR;
    }
    for (;;) {
        const bool has_next = S.next(ui + 1, nxt);
        const char* nA = has_next ? (const char*)g.A + (size_t)nxt.pm * tstep : cA; const char* nB = has_next ? (const char*)g.Bt + (size_t)nxt.pn * tstep : cB;
        for (int t = 0; t < nt; t += 2) {
            const bool last = (t == nt - 2);
            const char* a1 = cA + (size_t)(t + 1) * kstep;
            const char* a2 = last ? nA : cA + (size_t)(t + 2) * kstep; const char* b2 = last ? nB : cB + (size_t)(t + 2) * kstep;
            const char* a3 = a2 + kstep; const char* b3 = b2 + kstep;
            if (last && has_next) S.a_ready(nxt);
            if constexpr (SP2) {
            PG8_LDB(B0, 0, 0); PG8_LDB(B1, 0, 1); PG8_SCHED; PG8_LDA(At, 0, 0); PG8_STAGE(PG8_SA(1, 1), a1 + hstep, voffA);
            PG8_WAIT_V(8); PG8_WAIT_L(0); PG8_BAR; PG8_MMA(0, 0, At, B0); PG8_MMA(0, 1, At, B1); PG8_BAR; PG8_SCHED;
            PG8_LDA(At, 0, 1); PG8_STAGE(PG8_SB(0, 0), b2, voffB); PG8_STAGE(PG8_SB(0, 1), b2 + hstep, voffB); PG8_STAGE(PG8_SA(0, 0), a2, voffA);
            PG8_WAIT_V(8); PG8_WAIT_L(0); PG8_BAR; PG8_MMA(1, 0, At, B0); PG8_MMA(1, 1, At, B1); PG8_BAR; PG8_SCHED;
            PG8_LDB(B0, 1, 0); PG8_LDB(B1, 1, 1); PG8_SCHED; PG8_LDA(At, 1, 0); PG8_STAGE(PG8_SA(0, 1), a2 + hstep, voffA);
            PG8_WAIT_V(8); PG8_WAIT_L(0); PG8_BAR; PG8_MMA(0, 0, At, B0); PG8_MMA(0, 1, At, B1); PG8_BAR; PG8_SCHED;
            PG8_LDA(At, 1, 1); PG8_STAGE(PG8_SB(1, 0), b3, voffB); PG8_STAGE(PG8_SB(1, 1), b3 + hstep, voffB); PG8_STAGE(PG8_SA(1, 0), a3, voffA);
            PG8_WAIT_V(8); PG8_WAIT_L(0); PG8_BAR; PG8_MMA(1, 0, At, B0); PG8_MMA(1, 1, At, B1); PG8_BAR; PG8_SCHED;
            } else {
            PG8_LDB(B0, 0, 0); PG8_SCHED; PG8_LDA(At, 0, 0); PG8_STAGE(PG8_SA(1, 1), a1 + hstep, voffA);
            PG8_WAIT_L(8); PG8_BAR; PG8_WAIT_L(0); PG8_MMA(0, 0, At, B0); PG8_BAR; PG8_SCHED;
            PG8_LDB(B1, 0, 1); PG8_STAGE(PG8_SB(0, 0), b2, voffB);
            PG8_BAR; PG8_WAIT_L(0); PG8_MMA(0, 1, At, B1); PG8_BAR;
            PG8_LDA(At, 0, 1); PG8_STAGE(PG8_SA(0, 0), a2, voffA);
            PG8_BAR; PG8_WAIT_L(0); PG8_MMA(1, 0, At, B0); PG8_BAR; PG8_SCHED;
            PG8_STAGE(PG8_SB(0, 1), b2 + hstep, voffB);
            PG8_WAIT_V(6); PG8_BAR; PG8_MMA(1, 1, At, B1); PG8_BAR;
            PG8_LDB(B0, 1, 0); PG8_SCHED; PG8_LDA(At, 1, 0); PG8_STAGE(PG8_SA(0, 1), a2 + hstep, voffA);
            PG8_WAIT_L(8); PG8_BAR; PG8_WAIT_L(0); PG8_MMA(0, 0, At, B0); PG8_BAR; PG8_SCHED;
            PG8_LDB(B1, 1, 1); PG8_STAGE(PG8_SB(1, 0), b3, voffB);
            PG8_BAR; PG8_WAIT_L(0); PG8_MMA(0, 1, At, B1); PG8_BAR;
            PG8_LDA(At, 1, 1); PG8_STAGE(PG8_SA(1, 0), a3, voffA);
            PG8_BAR; PG8_WAIT_L(0); PG8_MMA(1, 0, At, B0); PG8_BAR; PG8_SCHED;
            PG8_STAGE(PG8_SB(1, 1), b3 + hstep, voffB);
            PG8_WAIT_V(6); PG8_BAR; PG8_MMA(1, 1, At, B1); PG8_BAR;
            }
        }
        if constexpr (ALIGN_EPI) { if (wr == 0) PG8_BAR; }
        if constexpr (!Epi::AFTER_DRAIN) { E(acc, cur, wr, wc, fr, fq); S.done(cur); }
        if (!has_next) break;
#pragma unroll
        for (int a = 0; a < 2; ++a)
#pragma unroll
            for (int b = 0; b < 2; ++b)
#pragma unroll
                for (int m = 0; m < 4; ++m)
#pragma unroll
                    for (int n = 0; n < 2; ++n) acc[a][b][m][n] = (f32x4){0.f, 0.f, 0.f, 0.f};
        cur = nxt; cA = nA; cB = nB; ++ui;
        if constexpr (ALIGN_EPI) { if (wr == 1) PG8_BAR; }
    }
    PG8_WAIT_V(0);
    if constexpr (!ALIGN_EPI) { if (wr == 0) PG8_BAR; }
    PG8_BAR;
    if constexpr (Epi::AFTER_DRAIN) { E.fused(acc, cur, wr, wc, fr, fq, lds, wid, lane); S.done(cur); }
#undef PG8_SA
#undef PG8_SB
#undef PG8_STAGE
#undef PG8_LDA
#undef PG8_LDB
#undef PG8_MMA
#undef PG8_WAIT_V
#undef PG8_WAIT_L
#undef PG8_BAR
#undef PG8_SCHED
}
}
#include <hip/hip_bf16.h>
#include <cmath>
namespace attn_body {
using bf16=__hip_bfloat16;
using bf16x8=__attribute__((ext_vector_type(8)))short;
using s16x4=__attribute__((ext_vector_type(4)))short;
using f32x16=__attribute__((ext_vector_type(16)))float;
using u32x4=__attribute__((ext_vector_type(4)))unsigned;
using f32x4=__attribute__((ext_vector_type(4)))float;
using u32x2=__attribute__((ext_vector_type(2)))unsigned;
constexpr int D=64,QP=1024;
constexpr int NW=8,QBLK=32,QB=QBLK*NW,KVBLK=64;
__device__ __forceinline__ int crow(int r,int hi){return (r&3)+8*(r>>2)+4*hi;}
#define SBAR() __builtin_amdgcn_sched_barrier(0)
__device__ __forceinline__ void bmask(f32x16&p0,f32x16&p1,int dlt,int hi){
  const float NEG=-INFINITY; const int kb=dlt+4*hi;
  #pragma unroll
  for(int r=0;r<16;++r){const int kv=kb+(r&3)+8*(r>>2); if(kv>128||kv<-128)p0[r]=NEG; if(kv+32>128||kv+32<-128)p1[r]=NEG;}
}

constexpr int NSLOT=3, SLOTB=8192;
constexpr int LDS_K=0, LDS_V=NSLOT*SLOTB, LDS_WS=2*NSLOT*SLOTB, LDS_OST=LDS_WS+NW*64*4, LDS_BYTES=LDS_OST+NW*8192;
__device__ __forceinline__ void glds16(const void*gsrc,unsigned lds_dst){unsigned keep;
  asm volatile("s_mov_b32 %0, m0\n\ts_mov_b32 m0, %2\n\ts_nop 0\n\tglobal_load_lds_dwordx4 %1, off\n\ts_mov_b32 m0, %0":"=&s"(keep):"v"(gsrc),"s"(lds_dst):"memory");}
__device__ __forceinline__ float max3f(float a,float b,float c){float r;asm("v_max3_f32 %0, %1, %2, %3":"=v"(r):"v"(a),"v"(b),"v"(c));return r;}
__device__ __forceinline__ float max2f(float a,float b){float r;asm("v_max_f32_e32 %0, %1, %2":"=v"(r):"v"(a),"v"(b));return r;}
__device__ __forceinline__ float fadd_s(float a,float b){float r;asm("v_add_f32_e32 %0, %1, %2":"=v"(r):"v"(a),"v"(b));return r;}
__device__ __forceinline__ float fsub_s(float a,float b){float r;asm("v_sub_f32_e32 %0, %1, %2":"=v"(r):"v"(a),"v"(b));return r;}
typedef float f32x2_t __attribute__((ext_vector_type(2))); typedef __bf16 bf16x2_t __attribute__((ext_vector_type(2)));
__device__ __forceinline__ unsigned cvtpk_s(float lo,float hi){f32x2_t v={lo,hi};bf16x2_t b=__builtin_convertvector(v,bf16x2_t);return __builtin_bit_cast(unsigned,b);}
#define WAIT_BAR(N) asm volatile("s_waitcnt vmcnt(" #N ") lgkmcnt(0)\n\ts_barrier":::"memory")

__device__ __forceinline__ void qkt(f32x16&p0,f32x16&p1,const char*Kslot,const bf16x8*qr,const f32x16&negm,int r32,int hi){
  const char*kb=Kslot+hi*1024+r32*16;
  #pragma unroll
  for(int d0=0;d0<4;++d0){
    const bf16x8 b0=*reinterpret_cast<const bf16x8*>(kb+d0*2048);
    const bf16x8 b1=*reinterpret_cast<const bf16x8*>(kb+d0*2048+512);
    if(d0==0){p0=__builtin_amdgcn_mfma_f32_32x32x16_bf16(b0,qr[0],negm,0,0,0);p1=__builtin_amdgcn_mfma_f32_32x32x16_bf16(b1,qr[0],negm,0,0,0);}
    else{p0=__builtin_amdgcn_mfma_f32_32x32x16_bf16(b0,qr[d0],p0,0,0,0);p1=__builtin_amdgcn_mfma_f32_32x32x16_bf16(b1,qr[d0],p1,0,0,0);}}
}
typedef __attribute__((address_space(3))) const char* lds_cptr;
typedef short v4i16_t __attribute__((ext_vector_type(4)));
__device__ __forceinline__ void kload8(bf16x8*kf,lds_cptr kp){
  kf[0]=*(const __attribute__((address_space(3))) bf16x8*)(kp);      kf[1]=*(const __attribute__((address_space(3))) bf16x8*)(kp+512);
  kf[2]=*(const __attribute__((address_space(3))) bf16x8*)(kp+2048); kf[3]=*(const __attribute__((address_space(3))) bf16x8*)(kp+2560);
  kf[4]=*(const __attribute__((address_space(3))) bf16x8*)(kp+4096); kf[5]=*(const __attribute__((address_space(3))) bf16x8*)(kp+4608);
  kf[6]=*(const __attribute__((address_space(3))) bf16x8*)(kp+6144); kf[7]=*(const __attribute__((address_space(3))) bf16x8*)(kp+6656);
}
__device__ __forceinline__ void kload2(bf16x8*kf,lds_cptr kp,int j){ kf[2*j]=*(const __attribute__((address_space(3))) bf16x8*)(kp+j*2048); kf[2*j+1]=*(const __attribute__((address_space(3))) bf16x8*)(kp+j*2048+512); }
__device__ __forceinline__ s16x4 vtr(lds_cptr p){ return __builtin_bit_cast(s16x4,__builtin_amdgcn_ds_read_tr16_b64_v4i16((__attribute__((address_space(3))) v4i16_t*)p)); }
__device__ __forceinline__ float rowmax(const f32x16&p0,const f32x16&p1){
  float a=max3f(p0[0],p0[1],p1[0]),b=max3f(p0[2],p0[3],p1[1]);a=max3f(a,p1[2],p1[3]);
  #pragma unroll
  for(int r=4;r<16;r+=4){a=max3f(a,p0[r],p0[r+1]);b=max3f(b,p0[r+2],p0[r+3]);a=max3f(a,p1[r],p1[r+1]);b=max3f(b,p1[r+2],p1[r+3]);}
  const float m=max2f(a,b);
  auto rr=__builtin_amdgcn_permlane32_swap(__float_as_uint(m),__float_as_uint(m),false,false);
  return max2f(__uint_as_float(rr[0]),__uint_as_float(rr[1]));
}
__device__ __forceinline__ void pv(f32x16*o,int vb,bf16x8 pa0,bf16x8 pa1,bf16x8 pa2,bf16x8 pa3){
  #pragma unroll
  for(int d0=0;d0<2;++d0){s16x4 lo[4],hi[4];
    #pragma unroll
    for(int ks=0;ks<4;++ks){
      asm volatile("ds_read_b64_tr_b16 %0,%1 offset:%c2":"=&v"(lo[ks]):"v"(vb),"i"(d0*4096+ks*1024):"memory");
      asm volatile("ds_read_b64_tr_b16 %0,%1 offset:%c2":"=&v"(hi[ks]):"v"(vb),"i"(d0*4096+ks*1024+512):"memory");}
    asm volatile("s_waitcnt lgkmcnt(0)":::"memory");SBAR();
    #define PK(k) (bf16x8){lo[k][0],lo[k][1],lo[k][2],lo[k][3],hi[k][0],hi[k][1],hi[k][2],hi[k][3]}
    o[d0]=__builtin_amdgcn_mfma_f32_32x32x16_bf16(pa0,PK(0),o[d0],0,0,0);
    o[d0]=__builtin_amdgcn_mfma_f32_32x32x16_bf16(pa1,PK(1),o[d0],0,0,0);
    o[d0]=__builtin_amdgcn_mfma_f32_32x32x16_bf16(pa2,PK(2),o[d0],0,0,0);
    o[d0]=__builtin_amdgcn_mfma_f32_32x32x16_bf16(pa3,PK(3),o[d0],0,0,0);
    #undef PK
  }
}

#ifndef ATTN_STORE16
#define ATTN_STORE16(p,v) (*(u32x4*)(p)=(v))
#endif
struct AU { const bf16* Q; bf16* O; const bf16* K; const bf16* V; int kvp; int NT; int koff; int mode; int q0; float sink_l2; float* scr; float lam; const float* gsub; float sub_scale; };
template<int THRL,bool MASK> __device__ __forceinline__ void attn_unit(const AU&a,char*shm){
  int tid_=threadIdx.x; asm volatile("":"+v"(tid_)); const int tid=tid_,lane=tid&63,r32=lane&31,hi=lane>>5; const int wid=__builtin_amdgcn_readfirstlane(tid>>6);
  const bf16*Qw=a.Q+(long)(wid*QBLK)*QP;
  const bf16*Kh=a.K,*Vh=a.V; const long kvp=a.kvp; const int koff=a.koff;
  const unsigned lds0=(unsigned)(uintptr_t)shm;
  float*wsf=(float*)(shm+LDS_WS)+wid*64;
  const bf16*ksrc=Kh+(long)lane*kvp+wid*8;
  const bf16*vsrc=Vh+(long)(16*(wid&3)+(lane>>2))*kvp+(wid>>2)*32+(lane&3)*8;
  const unsigned kdst=lds0+LDS_K+wid*1024, vdst=lds0+LDS_V+wid*1024;
  #define TROW(t) (KVBLK*(t)+(((t)>=4)?koff:0))
  #define DMA_K(t,slot) glds16(ksrc+(long)TROW(t)*kvp,(unsigned)__builtin_amdgcn_readfirstlane(kdst+(slot)))
  #define DMA_V(t,slot) glds16(vsrc+(long)TROW(t)*kvp,(unsigned)__builtin_amdgcn_readfirstlane(vdst+(slot)))
  const int vb0=(int)(lds0+LDS_V)+((lane>>4)&1)*32+(lane&3)*8+(4*hi+((lane&15)>>2))*64;
  const char*Kbase=shm+LDS_K; bf16x8 kf[8];
  const lds_cptr shm3=(lds_cptr)shm; const lds_cptr kp0=shm3+LDS_K+hi*1024+r32*16; const lds_cptr vp0=shm3+LDS_V+((lane>>4)&1)*32+(lane&3)*8+(4*hi+((lane&15)>>2))*64;
  const int NT=a.NT;
  DMA_K(0,0);DMA_V(0,0);DMA_K(1,SLOTB);
  bf16x8 qr[4];
  #pragma unroll
  for(int d0=0;d0<4;++d0)qr[d0]=*reinterpret_cast<const bf16x8*>(&Qw[(long)r32*QP+d0*16+hi*8]);
  if(a.mode==2){qr[2]=bf16x8{};qr[3]=bf16x8{};} else if(a.mode==3){qr[0]=bf16x8{};qr[1]=bf16x8{};}
  float mhat=0.f,l_reg=0.f;f32x16 o[2];o[0]=f32x16{};o[1]=f32x16{};f32x16 negm=f32x16{};asm volatile("":"+v"(negm));
  const int qpos=a.q0+wid*QBLK+r32;
  #define CMASK(P0,P1,t) do{ if(MASK){ if((t)>=4) bmask(P0,P1,koff+KVBLK*((t)-4)-qpos,hi); } }while(0)
  bool resc=false;
  #define START(P0,P1) do{ const float rm=rowmax(P0,P1); resc=false; \
    { const float dl=rm; mhat=fadd_s(mhat,dl); \
      _Pragma("unroll") for(int r=0;r<16;++r){P0[r]=fsub_s(P0[r],dl);P1[r]=fsub_s(P1[r],dl);} \
      _Pragma("unroll") for(int r=0;r<16;++r)negm[r]=-mhat; asm volatile("":"+v"(negm)); } \
    _Pragma("unroll") for(int r=0;r<16;++r)P0[r]=__builtin_amdgcn_exp2f(P0[r]); }while(0)
  #define RESC() do{ if(resc){ asm volatile("s_waitcnt lgkmcnt(0)":::"memory"); \
      _Pragma("unroll") for(int d_=0;d_<2;++d_) _Pragma("unroll") for(int r=0;r<16;++r)o[d_][r]*=wsf[crow(r,hi)]; } }while(0)
  f32x16 pA0,pA1,pB0,pB1;
  int sl_prev=0,sl_cur=0,sl_next=SLOTB;
  #define ROT() do{sl_prev=sl_cur;sl_cur=sl_next;sl_next=(sl_next==(NSLOT-1)*SLOTB)?0:sl_next+SLOTB;}while(0)
  DMA_K(2,2*SLOTB);
  WAIT_BAR(3);
  qkt(pA0,pA1,Kbase,qr,negm,r32,hi);asm volatile("s_nop 15\n\ts_nop 7":"+v"(pA0),"+v"(pA1));CMASK(pA0,pA1,0);
  START(pA0,pA1);
  _Pragma("unroll") for(int r=0;r<16;++r)pA1[r]=__builtin_amdgcn_exp2f(pA1[r]);
  WAIT_BAR(0);
  DMA_K(3,0);DMA_V(1,SLOTB);
  ROT();
  kload8(kf,kp0+sl_cur);
  WAIT_BAR(2);
  s16x4 vlo[8],vhi[8]; u32x4 pw0,pw1,pw2,pw3;
  #define PKW(P,B) cvtpk_s(P[B],P[B+1])
  #define PAF(k) __builtin_bit_cast(bf16x8,pw##k)
  #define VFR(i) (bf16x8){vlo[i][0],vlo[i][1],vlo[i][2],vlo[i][3],vhi[i][0],vhi[i][1],vhi[i][2],vhi[i][3]}
  #define PIN(x) asm volatile("":"+v"(x))
  #define MX3(a,b,c) __builtin_fmaxf(__builtin_fmaxf((a),(b)),(c))
  #define GAPA(MF,A0,A1,A2,A3,W0,W1,PW) do{ MF; sacc+=A0; sacc+=A1; sacc+=A2; sacc+=A3; PIN(sacc); W0; W1; PIN(PW); SBAR(); }while(0)
  #define EX(v) __builtin_amdgcn_exp2f(v)
  #define GAPB(MF,X,B) do{ MF; X[B]=EX(X[B]); X[B+1]=EX(X[B+1]); X[B+2]=EX(X[B+2]); X[B+3]=EX(X[B+3]); PIN(X); SBAR(); }while(0)
  #define VRD(i) do{ vlo[i]=vtr(vp_+(((i)>>2)*4096+((i)&3)*1024)); vhi[i]=vtr(vp_+(((i)>>2)*4096+((i)&3)*1024+512)); }while(0)
  #define KRD(G,j) do{ if(G){ kload2(kf,kp0+sl_next,j); SBAR(); } }while(0)
  #define STEP(C0,C1,P0,P1,t,GK,GV,GL) do{ SBAR(); \
    const lds_cptr vp_=vp0+sl_prev; \
    VRD(0); SBAR(); float sacc=(P0[0]+P0[1]); \
    GAPA(C0=__builtin_amdgcn_mfma_f32_32x32x16_bf16(kf[0],qr[0],negm,0,0,0), P0[2],P0[3],P0[4],P0[5],     pw0[0]=PKW(P0,0), pw0[1]=PKW(P0,2), pw0); \
    VRD(4); SBAR(); GAPA(C1=__builtin_amdgcn_mfma_f32_32x32x16_bf16(kf[1],qr[0],negm,0,0,0), P0[6],P0[7],P0[8],P0[9],     pw0[2]=PKW(P0,4), pw0[3]=PKW(P0,6), pw0); \
    VRD(1); SBAR(); GAPA(C0=__builtin_amdgcn_mfma_f32_32x32x16_bf16(kf[2],qr[1],C0,0,0,0),   P0[10],P0[11],P0[12],P0[13], pw1[0]=PKW(P0,8), pw1[1]=PKW(P0,10), pw1); \
    VRD(5); SBAR(); GAPA(C1=__builtin_amdgcn_mfma_f32_32x32x16_bf16(kf[3],qr[1],C1,0,0,0),   P0[14],P0[15],P1[0],P1[1],   pw1[2]=PKW(P0,12),pw1[3]=PKW(P0,14), pw1); \
    VRD(2); SBAR(); GAPA(C0=__builtin_amdgcn_mfma_f32_32x32x16_bf16(kf[4],qr[2],C0,0,0,0),   P1[2],P1[3],P1[4],P1[5],     pw2[0]=PKW(P1,0), pw2[1]=PKW(P1,2), pw2); \
    VRD(6); SBAR(); GAPA(C1=__builtin_amdgcn_mfma_f32_32x32x16_bf16(kf[5],qr[2],C1,0,0,0),   P1[6],P1[7],P1[8],P1[9],     pw2[2]=PKW(P1,4), pw2[3]=PKW(P1,6), pw2); \
    VRD(3); SBAR(); GAPA(C0=__builtin_amdgcn_mfma_f32_32x32x16_bf16(kf[6],qr[3],C0,0,0,0),   P1[10],P1[11],P1[12],P1[13], pw3[0]=PKW(P1,8), pw3[1]=PKW(P1,10), pw3); \
    VRD(7); SBAR(); GAPA(C1=__builtin_amdgcn_mfma_f32_32x32x16_bf16(kf[7],qr[3],C1,0,0,0),   P1[14],P1[15],0.f,0.f,       pw3[2]=PKW(P1,12),pw3[3]=PKW(P1,14), pw3); \
    l_reg+=sacc; \
    if(GK){DMA_K((t)+3,sl_cur);} if(GV){DMA_V((t)+1,sl_next);} \
    CMASK(C0,C1,t); \
    { float a=MX3(C0[0],C0[1],C1[0]),b=MX3(C0[2],C0[3],C1[1]); a=MX3(a,C1[2],C1[3]); \
      _Pragma("unroll") for(int r=4;r<16;r+=4){a=MX3(a,C0[r],C0[r+1]);b=MX3(b,C0[r+2],C0[r+3]);a=MX3(a,C1[r],C1[r+1]);b=MX3(b,C1[r+2],C1[r+3]);} \
      float rm=__builtin_fmaxf(a,b); { auto rr=__builtin_amdgcn_permlane32_swap(__float_as_uint(rm),__float_as_uint(rm),false,false); rm=__builtin_fmaxf(__uint_as_float(rr[0]),__uint_as_float(rr[1])); } \
      resc=false; \
      if(__builtin_expect(__any(rm>(float)THRL),0)){ const float dl=__builtin_fmaxf(rm,0.f); mhat+=dl; \
        _Pragma("unroll") for(int r=0;r<16;++r){C0[r]-=dl;C1[r]-=dl;} \
        _Pragma("unroll") for(int r=0;r<16;++r)negm[r]=-mhat; asm volatile("":"+v"(negm)); \
        const float f=__builtin_amdgcn_exp2f(-dl); l_reg*=f; if(hi==0)wsf[r32]=f; resc=true; } } \
    SBAR(); \
    GAPB(o[0]=__builtin_amdgcn_mfma_f32_32x32x16_bf16(PAF(0),VFR(0),o[0],0,0,0), C0,0); \
    GAPB(o[1]=__builtin_amdgcn_mfma_f32_32x32x16_bf16(PAF(0),VFR(4),o[1],0,0,0), C0,4); \
    KRD(GL,0); GAPB(o[0]=__builtin_amdgcn_mfma_f32_32x32x16_bf16(PAF(1),VFR(1),o[0],0,0,0), C0,8); \
    KRD(GL,1); GAPB(o[1]=__builtin_amdgcn_mfma_f32_32x32x16_bf16(PAF(1),VFR(5),o[1],0,0,0), C0,12); \
    KRD(GL,2); GAPB(o[0]=__builtin_amdgcn_mfma_f32_32x32x16_bf16(PAF(2),VFR(2),o[0],0,0,0), C1,0); \
    KRD(GL,3); GAPB(o[1]=__builtin_amdgcn_mfma_f32_32x32x16_bf16(PAF(2),VFR(6),o[1],0,0,0), C1,4); \
    GAPB(o[0]=__builtin_amdgcn_mfma_f32_32x32x16_bf16(PAF(3),VFR(3),o[0],0,0,0), C1,8); \
    GAPB(o[1]=__builtin_amdgcn_mfma_f32_32x32x16_bf16(PAF(3),VFR(7),o[1],0,0,0), C1,12); \
    }while(0)
  int t=1;
  for(;t+5<NT;t+=2){
    STEP(pB0,pB1,pA0,pA1,t,true,true,true);     WAIT_BAR(2); RESC(); ROT();
    STEP(pA0,pA1,pB0,pB1,t+1,true,true,true);   WAIT_BAR(2); RESC(); ROT();
  }
  #define ENDW(tt) do{ if((tt)+3<NT){WAIT_BAR(2);} else if((tt)+2<NT){WAIT_BAR(1);} else {WAIT_BAR(0);} }while(0)
  for(;t+1<NT;t+=2){
    STEP(pB0,pB1,pA0,pA1,t,(t+3<NT),(t+1<NT),(t+1<NT));       ENDW(t);   RESC(); ROT();
    STEP(pA0,pA1,pB0,pB1,t+1,(t+4<NT),(t+2<NT),(t+2<NT));     ENDW(t+1); RESC(); ROT();
  }
  STEP(pB0,pB1,pA0,pA1,NT-1,false,false,false); RESC();
  { float sacc=pB0[0]+pB0[1]; _Pragma("unroll") for(int r=2;r<16;++r)sacc+=pB0[r]; _Pragma("unroll") for(int r=0;r<16;++r)sacc+=pB1[r]; l_reg+=sacc;
    pw0=(u32x4){PKW(pB0,0),PKW(pB0,2),PKW(pB0,4),PKW(pB0,6)};pw1=(u32x4){PKW(pB0,8),PKW(pB0,10),PKW(pB0,12),PKW(pB0,14)};pw2=(u32x4){PKW(pB1,0),PKW(pB1,2),PKW(pB1,4),PKW(pB1,6)};pw3=(u32x4){PKW(pB1,8),PKW(pB1,10),PKW(pB1,12),PKW(pB1,14)};
    SBAR(); pv(o,vb0+sl_cur,PAF(0),PAF(1),PAF(2),PAF(3)); }
  #undef PKW
  #undef PAF
  #undef VFR
  #undef PIN
  #undef MX3
  #undef GAPA
  #undef GAPB
  #undef EX
  #undef VRD
  #undef KRD
  #undef STEP
  #undef ENDW
  {auto rr=__builtin_amdgcn_permlane32_swap(__float_as_uint(l_reg),__float_as_uint(l_reg),false,false);l_reg=__uint_as_float(rr[0])+__uint_as_float(rr[1]);}
  if(a.mode==1)l_reg+=__builtin_amdgcn_exp2f(a.sink_l2-mhat);
  if(hi==0)wsf[32+r32]=l_reg;asm volatile("s_waitcnt lgkmcnt(0)":::"memory");
  float rli[16];
  #pragma unroll
  for(int r=0;r<16;++r)rli[r]=__builtin_amdgcn_rcpf(wsf[32+crow(r,hi)]);
  bf16*Ow=a.O+(long)(wid*QBLK)*QP;
  if(a.mode==2){
    float*sc=a.scr+(long)wid*2048+lane;
    #pragma unroll
    for(int r=0;r<16;++r){
      #pragma unroll
      for(int d0=0;d0<2;++d0)sc[(2*r+d0)*64]=o[d0][r]*rli[r];}
  } else if(a.mode==3){
    const float*sc=a.scr+(long)wid*2048+lane; float*stf=(float*)(shm+LDS_OST)+wid*2048; float*pst=stf+hi*256+r32;
    #pragma unroll
    for(int r=0;r<16;++r){
      #pragma unroll
      for(int d0=0;d0<2;++d0)pst[((r&3)+8*(r>>2))*64+d0*32]=sc[(2*r+d0)*64]-a.lam*(o[d0][r]*rli[r]);}
    asm volatile("s_waitcnt lgkmcnt(0)":::"memory");
    const int c4=lane&15; const f32x4 gs4=*(const f32x4*)(a.gsub+4*c4); const float*prd=stf+(lane>>4)*64+4*c4; bf16*pwr=Ow+(long)(lane>>4)*QP+4*c4;
    #pragma unroll
    for(int i=0;i<8;++i){f32x4 v=*(const f32x4*)(prd+i*256);
      float ss=(v[0]*v[0]+v[1]*v[1])+(v[2]*v[2]+v[3]*v[3]); ss+=__shfl_xor(ss,1); ss+=__shfl_xor(ss,2); ss+=__shfl_xor(ss,4); ss+=__shfl_xor(ss,8);
      const float rn=rsqrtf(ss*(1.0f/64.0f)+1e-6f)*a.sub_scale; v=v*rn*gs4;
      u32x2 pk; pk.x=cvtpk_s(v[0],v[1]); pk.y=cvtpk_s(v[2],v[3]); *(u32x2*)(pwr+(long)i*4*QP)=pk;}
  } else
  { bf16*stg=(bf16*)(shm+LDS_OST)+wid*2048;
    #pragma unroll
    for(int r=0;r<16;++r){const int orow=crow(r,hi);
      #pragma unroll
      for(int d0=0;d0<2;++d0)stg[orow*64+d0*32+r32]=__float2bfloat16(o[d0][r]*rli[r]);}
    asm volatile("s_waitcnt lgkmcnt(0)":::"memory");
    #pragma unroll
    for(int i=0;i<4;++i){const int row=i*8+(lane>>3),ch=lane&7; const u32x4 v=*(const u32x4*)(stg+row*64+ch*8); ATTN_STORE16(Ow+(long)row*QP+ch*8,v);} }
  asm volatile("s_waitcnt lgkmcnt(0)\n\ts_barrier":::"memory");
  #undef DMA_K
  #undef DMA_V
  #undef CMASK
  #undef START
  #undef RESC
  #undef TROW
  #undef ROT
}
constexpr int ATTN_LDS_BYTES=LDS_BYTES;
#undef SBAR
#undef WAIT_BAR
}

constexpr int NWAVES = 8;
#ifndef MK_N_LAUNCHES
#define MK_N_LAUNCHES 1
#endif
constexpr int DEPTH = 2, DMODEL = 1024, DIN = 2048, DUP = 5632, DFF = 2816, NTOK = 12288, NPROMPT = 4096;
constexpr int N_PHASES = 2 + 6 * DEPTH + 1;
constexpr size_t MiB = 1u << 20;
constexpr size_t WS_CTL = 0, CTL_ZERO_BYTES = 1 * MiB;
constexpr int CW_TMO = 0, CW_CODE = 1, CW_BAR = 4096, CW_QUEUE = 8192;
constexpr size_t CTL_SUMSQ = 64 * 1024;
constexpr size_t CTL_MOD = 256 * 1024;
constexpr size_t CTL_CIN = 400 * 1024;
constexpr size_t CTL_CUP = 448 * 1024;
static_assert(CTL_CUP + (size_t)DEPTH * 3 * DUP * 4 <= CTL_ZERO_BYTES && CTL_SUMSQ + 4 * (size_t)NTOK * 4 <= CTL_MOD && CTL_MOD + (size_t)DEPTH * 3 * 6144 * 4 <= CTL_CIN && CTL_CIN + (size_t)DEPTH * 3 * DIN * 4 <= CTL_CUP, "ctl map");
constexpr size_t WS_SS0 = 1 * MiB;
constexpr size_t WS_ROPE = WS_SS0 + 64 * 1024;
constexpr size_t WS_LAM = WS_ROPE + 16 * 1024;
constexpr size_t WS_W = 2 * MiB;
constexpr size_t W_IN_OFF = 0, W_OUT_OFF = 4 * MiB, W_UP_OFF = 6 * MiB, W_DOWN_OFF = 17 * MiB, W_LAYER = 22 * MiB + MiB / 2;
constexpr size_t WS_R1 = 48 * MiB;
constexpr size_t R1_H1 = 0, R1_QO = 24 * MiB, R1_KV = 48 * MiB;
constexpr size_t WS_R2 = 180 * MiB;
constexpr size_t R2_H2 = 0, R2_SCR = 24 * MiB;
constexpr size_t WS_END = 246 * MiB;
static_assert(WS_W + DEPTH * W_LAYER <= WS_R1 && R1_KV + (size_t)pg8::KV_ELEMS * 2 <= 132 * MiB && R2_SCR + (size_t)4 * NTOK * 64 * 4 <= 66 * MiB && (size_t)NTOK * DUP * 2 <= 132 * MiB && (size_t)NTOK * DFF * 2 <= 66 * MiB, "ws map");
constexpr int RING_OFF = 0, RING_BYTES = 131072;
constexpr int LDSCTL_OFF = RING_BYTES, MISC_OFF = LDSCTL_OFF + 320;
constexpr int LDS_BYTES = 147456;
static_assert(attn_body::ATTN_LDS_BYTES <= RING_BYTES, "attention scratch fits the ring region");

#define GAS __attribute__((address_space(1)))
#define LAS __attribute__((address_space(3)))
typedef unsigned short bf16;
typedef unsigned v4u __attribute__((ext_vector_type(4)));
typedef float f32x4 __attribute__((ext_vector_type(4)));
typedef short bf16x8 __attribute__((ext_vector_type(8)));
typedef GAS unsigned gu32;
typedef GAS unsigned long long gu64;
#define RLX_AGENT __ATOMIC_RELAXED, __HIP_MEMORY_SCOPE_AGENT
#define LDS_WAIT() asm volatile("s_waitcnt lgkmcnt(0)" ::: "memory")
#define VM_WAIT() asm volatile("s_waitcnt vmcnt(0)" ::: "memory")
__device__ __forceinline__ unsigned long long rt() { return __builtin_amdgcn_s_memrealtime(); }
__device__ __forceinline__ unsigned f2bf(float f) { unsigned u = __builtin_bit_cast(unsigned, f); return (u + 0x7fffu + ((u >> 16) & 1u)) >> 16; }
__device__ __forceinline__ unsigned pk2(float lo, float hi) { return f2bf(lo) | (f2bf(hi) << 16); }

#define XB_TMO      128
#define XB_XCNT(j)  (256  + 64 * (j))
#define XB_XSUB(j)  (1280 + 64 * (j))
#define XB_XGEN(j)  (2304 + 64 * (j))
#define XB_TOP      3328
#define XB_TOPGEN   3392
#define XCD_BAR_WORDS 3456
#define XB_SPIN_CAP (1u << 18)

__device__ __forceinline__ unsigned xb_ld(unsigned* p)              { return __hip_atomic_load(p, __ATOMIC_RELAXED, __HIP_MEMORY_SCOPE_AGENT); }
__device__ __forceinline__ unsigned xb_add(unsigned* p, unsigned v) { return __hip_atomic_fetch_add(p, v, __ATOMIC_RELAXED, __HIP_MEMORY_SCOPE_AGENT); }
__device__ __forceinline__ unsigned xb_xcc_id() { return (unsigned)__builtin_amdgcn_s_getreg((3 << 11) | 20) & 0xFu; }
#define XB_SPIN(cond, bar) do { unsigned _sp = 0; while (cond) { __builtin_amdgcn_s_sleep(1); \
    if ((++_sp & 255u) == 0u) { if (xb_ld(&(bar)[XB_TMO])) break; if (_sp > XB_SPIN_CAP) { atomicAdd(&(bar)[XB_TMO], 1u); break; } } } } while (0)

struct XcdBarrier {
    unsigned* bar; unsigned x;
    volatile LAS unsigned* st;
};

__device__ __forceinline__ XcdBarrier xcd_barrier_post(unsigned* bar, volatile LAS unsigned* st) {
    XcdBarrier b; b.bar = bar; b.x = xb_xcc_id(); b.st = st;
    if (threadIdx.x == 0) (void)xb_add(&bar[XB_XCNT(b.x)], 1u);
    return b;
}
__device__ __forceinline__ void xcd_barrier_complete(unsigned* bar, unsigned x, unsigned& nloc, unsigned& nx) {
    const unsigned G = gridDim.x * gridDim.y * gridDim.z;
    unsigned sum, cnt, mine, sp = 0u;
    for (;;) {
        sum = 0u; cnt = 0u; mine = 0u;
#pragma unroll
        for (unsigned j = 0; j < 16; ++j) { const unsigned c = xb_ld(&bar[XB_XCNT(j)]); sum += c; cnt += (c > 0u) ? 1u : 0u; mine = (j == x) ? c : mine; }
        if (sum == G) break;
        __builtin_amdgcn_s_sleep(1);
        if ((++sp & 255u) == 0u) { if (xb_ld(&bar[XB_TMO])) break; if (sp > XB_SPIN_CAP) { atomicAdd(&bar[XB_TMO], 1u); break; } }
    }
    nloc = mine > 0u ? mine : 1u; nx = cnt > 0u ? cnt : 1u;
}

__device__ __forceinline__ void xcd_barrier(const XcdBarrier& b) {
    asm volatile("s_waitcnt vmcnt(0)" ::: "memory");
    __syncthreads();
    if (threadIdx.x == 0) {
        unsigned* bar = b.bar;
        __builtin_amdgcn_s_waitcnt(0);
        unsigned nloc = b.st[0], nx = b.st[1];
        if (nloc == 0u) { xcd_barrier_complete(bar, b.x, nloc, nx); b.st[0] = nloc; b.st[1] = nx; }
        const unsigned old = xb_add(&bar[XB_XSUB(b.x)], 1u);
        const unsigned gen = old / nloc;
        if (old + 1u == (gen + 1u) * nloc) {
            __builtin_amdgcn_fence(__ATOMIC_RELEASE, "agent");
            asm volatile("s_waitcnt vmcnt(0)" ::: "memory");
            const unsigned og = xb_add(&bar[XB_TOP], 1u);
            const unsigned tg = og / nx;
            if (og + 1u == (tg + 1u) * nx) xb_add(&bar[XB_TOPGEN], 1u);
            else XB_SPIN(xb_ld(&bar[XB_TOPGEN]) == tg, bar);
            __builtin_amdgcn_fence(__ATOMIC_ACQUIRE, "agent");
            xb_add(&bar[XB_XGEN(b.x)], 1u);
            asm volatile("s_waitcnt vmcnt(0)" ::: "memory");
        } else {
            XB_SPIN(xb_ld(&bar[XB_XGEN(b.x)]) == gen, bar);
            __builtin_amdgcn_fence(__ATOMIC_ACQUIRE, "agent");
            asm volatile("s_waitcnt vmcnt(0)" ::: "memory");
        }
    }
    __syncthreads();
}


struct Frame {
    LAS unsigned char* lds; volatile LAS unsigned* MISC; gu32* ctl;
    int tid, lane, wave, vcu, G;
    const float* const* in; float* out; unsigned char* ws;
};
__device__ __forceinline__ float wave_sum(float v) {
#pragma unroll
    for (int o = 1; o < 64; o <<= 1) v += __shfl_xor(v, o);
    return v;
}
template <class T> __device__ __forceinline__ T* uni(T* p) {
    const unsigned long long v = (unsigned long long)p; const unsigned lo = __builtin_amdgcn_readfirstlane((unsigned)v), hi = __builtin_amdgcn_readfirstlane((unsigned)(v >> 32));
    return (T*)(GAS T*)(((unsigned long long)hi << 32) | lo);
}
__device__ __forceinline__ float silu_f(float x) { return x / (1.0f + __expf(-x)); }

__device__ __forceinline__ int phys_in(int L) {
    const int g = L >> 6, d = L & 63, pn = g >> 2, wc = g & 3, bj = d >> 5; int n, fq, j;
    if (g >= 20 && g < 28) { const int x = d & 31, p = x >> 4, i = x & 7; n = (x >> 3) & 1; fq = 2 * p + (i >> 2); j = i & 3; }
    else { n = (d >> 4) & 1; fq = (d >> 2) & 3; j = d & 3; }
    return 256 * pn + 128 * bj + 32 * wc + 16 * n + 4 * fq + j;
}
__device__ __forceinline__ int phys_up(int L) {
    const int pn = L >> 8, c = L & 255, bj = c >> 7, wc = (c >> 5) & 3, y = c & 31, fq = y >> 3, n = (y >> 2) & 1, j = y & 3;
    return 256 * pn + 128 * bj + 32 * wc + 16 * n + 4 * fq + j;
}
template <int PM> __device__ __forceinline__ void transpose_item(const float* W, int K, int N, bf16* WT, LAS float* scr, int item, int lane, const float* shp, float* cdst) {
    const int nblk = N / 32, kb = item / nblk, nb = item % nblk, k0 = 64 * kb, n0 = 32 * nb;
#pragma unroll 8
    for (int i = 0; i < 32; ++i) { const int kk = 2 * i + (lane >> 5); scr[kk * 33 + (lane & 31)] = W[(size_t)(k0 + kk) * N + n0 + (lane & 31)]; }
    LDS_WAIT(); asm volatile("" ::: "memory");
    const int c = lane & 7;
#pragma unroll
    for (int j = 0; j < 4; ++j) { const int n = (lane >> 3) + 8 * j; const LAS float* s = scr + (8 * c) * 33 + n;
        v4u o; o.x = pk2(s[0 * 33], s[1 * 33]); o.y = pk2(s[2 * 33], s[3 * 33]); o.z = pk2(s[4 * 33], s[5 * 33]); o.w = pk2(s[6 * 33], s[7 * 33]);
        const int L = n0 + n, row = (PM == 1) ? phys_in(L) : (PM == 2) ? phys_up(L) : L;
        *(GAS v4u*)(WT + (size_t)row * K + k0 + 8 * c) = o; }
    if (shp) {
        const int n = lane & 31, kh = lane >> 5; float a0 = 0.f, a1 = 0.f, a2 = 0.f;
#pragma unroll 8
        for (int kk = 0; kk < 32; ++kk) { const float w = scr[(32 * kh + kk) * 33 + n]; const int k = k0 + 32 * kh + kk; a0 += shp[k] * w; a1 += shp[6144 + k] * w; a2 += shp[2 * 6144 + k] * w; }
        a0 += __shfl_xor(a0, 32); a1 += __shfl_xor(a1, 32); a2 += __shfl_xor(a2, 32);
        if (lane < 32) { unsafeAtomicAdd(cdst + n0 + n, a0); unsafeAtomicAdd(cdst + N + n0 + n, a1); unsafeAtomicAdd(cdst + 2 * N + n0 + n, a2); }
    }
    LDS_WAIT(); asm volatile("" ::: "memory");
}

__device__ __forceinline__ void relane(Frame& F) { int t = threadIdx.x; asm volatile("" : "+v"(t)); F.tid = t; F.lane = t & 63; F.wave = __builtin_amdgcn_readfirstlane(t >> 6); }
__device__ __forceinline__ void p0a(Frame& F) {
    relane(F);
    LAS float* sil = (LAS float*)(F.lds + RING_OFF);
    for (int i = F.tid; i < 3 * DMODEL; i += NWAVES * 64) { const int c = i >> 10, k = i & 1023; const float x = (c == 0) ? F.in[9][k] : F.in[8][(c - 1) * DMODEL + k]; sil[i] = silu_f(x); }
    __syncthreads();
    const int gw = F.vcu * NWAVES + F.wave, NGW = F.G * NWAVES;
    float* mod = (float*)(F.ws + WS_CTL + CTL_MOD);
    for (int it = gw; it < DEPTH * 24 * 32; it += NGW) {
        const int l = it / 768, r = it % 768, cb = r >> 5, kc = r & 31, col = cb * 256 + F.lane * 4;
        const float* wp = F.in[10] + ((size_t)l * DMODEL + kc * 32) * 6144 + col;
        f32x4 a0 = {0.f, 0.f, 0.f, 0.f}, a1 = a0, a2 = a0;
#pragma unroll 8
        for (int kk = 0; kk < 32; ++kk) { const f32x4 w = *(const f32x4*)(wp + (size_t)kk * 6144); const int k = kc * 32 + kk; a0 += w * sil[k]; a1 += w * sil[1024 + k]; a2 += w * sil[2048 + k]; }
        if (kc == 0) { const f32x4 b = *(const f32x4*)(F.in[11] + l * 6144 + col); a0 += b; a1 += b; a2 += b; }
        float* mp = mod + (size_t)l * 3 * 6144 + col;
#pragma unroll
        for (int j = 0; j < 4; ++j) { unsafeAtomicAdd(mp + j, a0[j]); unsafeAtomicAdd(mp + 6144 + j, a1[j]); unsafeAtomicAdd(mp + 2 * 6144 + j, a2[j]); }
    }
    __syncthreads();
    LAS float* scr = (LAS float*)(F.lds + RING_OFF + F.wave * 16384);
    constexpr int I_O = (DMODEL / 64) * (DMODEL / 32), I_D = (DFF / 64) * (DMODEL / 32);
    for (int it = gw; it < DEPTH * (I_O + I_D); it += NGW) {
        const int l = it / (I_O + I_D); int r = it % (I_O + I_D);
        bf16* wl = (bf16*)(F.ws + WS_W + l * W_LAYER);
        if (r < I_O) transpose_item<0>(F.in[23] + (size_t)l * DMODEL * DMODEL, DMODEL, DMODEL, (bf16*)((unsigned char*)wl + W_OUT_OFF), scr, r, F.lane, nullptr, nullptr);
        else transpose_item<0>(F.in[27] + (size_t)l * DFF * DMODEL, DFF, DMODEL, (bf16*)((unsigned char*)wl + W_DOWN_OFF), scr, r - I_O, F.lane, nullptr, nullptr);
    }
    const int gt = F.vcu * NWAVES * 64 + F.tid;
    float* rope = (float*)(F.ws + WS_ROPE);
    if (gt < 1024) { const int pos = gt >> 4, i = gt & 15; const double ang = (double)pos * pow(10000.0, -(double)i / 16.0); rope[gt] = (float)cos(ang); rope[1024 + gt] = (float)sin(ang); }
    else if (gt < 1536) { const int q = gt - 1024, pos = q >> 3, i = q & 7; const double ang = (double)pos * pow(10000.0, -(double)i / 8.0); rope[2048 + q] = (float)cos(ang); rope[2560 + q] = (float)sin(ang); }
    else if (gt < 1536 + DEPTH) { const int l = gt - 1536; float s1 = 0.f, s2 = 0.f;
        for (int i = 0; i < 32; ++i) { s1 += F.in[18][l * 32 + i] * F.in[19][l * 32 + i]; s2 += F.in[20][l * 32 + i] * F.in[21][l * 32 + i]; }
        const float lam_init = 0.8f - 0.6f * expf(-0.3f * (float)l);
        ((float*)(F.ws + WS_LAM))[l] = expf(s1) - expf(s2) + lam_init; }
}
__device__ __forceinline__ void p0b(Frame& F) {
    relane(F);
    LAS float* scr = (LAS float*)(F.lds + RING_OFF + F.wave * 16384);
    const int gw = F.vcu * NWAVES + F.wave, NGW = F.G * NWAVES;
    const float* mod = (const float*)(F.ws + WS_CTL + CTL_MOD);
    constexpr int I_I = (DMODEL / 64) * (DIN / 32), I_U = (DMODEL / 64) * (DUP / 32);
    for (int it = gw; it < DEPTH * (I_I + I_U); it += NGW) {
        const int l = it / (I_I + I_U); int r = it % (I_I + I_U);
        unsigned char* wl = F.ws + WS_W + l * W_LAYER; const float* ml = mod + (size_t)l * 3 * 6144;
        if (r < I_I) transpose_item<1>(F.in[14] + (size_t)l * DMODEL * DIN, DMODEL, DIN, (bf16*)(wl + W_IN_OFF), scr, r, F.lane, ml + 0, (float*)(F.ws + WS_CTL + CTL_CIN) + (size_t)l * 3 * DIN);
        else transpose_item<2>(F.in[24] + (size_t)l * DMODEL * DUP, DMODEL, DUP, (bf16*)(wl + W_UP_OFF), scr, r - I_I, F.lane, ml + 3072, (float*)(F.ws + WS_CTL + CTL_CUP) + (size_t)l * 3 * DUP);
    }
    bf16* H1 = (bf16*)(F.ws + WS_R1 + R1_H1); float* ss0 = (float*)(F.ws + WS_SS0);
    for (int m = gw; m < NTOK; m += NGW) {
        const float* xr = (m < NPROMPT) ? F.in[0] + (size_t)m * DMODEL : F.in[1] + (size_t)(m - NPROMPT) * DMODEL;
        const int cond = (m < NPROMPT) ? 0 : 1 + ((m - NPROMPT) >> 12);
        const float* sc = mod + (size_t)cond * 6144 + 1024; const float* g1 = F.in[12];
        float s = 0.f; GAS unsigned long long* o8 = (GAS unsigned long long*)(H1 + (size_t)m * DMODEL) + F.lane;
#pragma unroll
        for (int j = 0; j < 4; ++j) { const int k = 4 * F.lane + 256 * j; const f32x4 v = *(const f32x4*)(xr + k); s += (v.x * v.x + v.y * v.y) + (v.z * v.z + v.w * v.w);
            const f32x4 w = v * (*(const f32x4*)(g1 + k)) * (*(const f32x4*)(sc + k) + 1.0f);
            o8[64 * j] = (unsigned long long)pk2(w.x, w.y) | ((unsigned long long)pk2(w.z, w.w) << 32); }
        s = wave_sum(s); if (F.lane == 0) ss0[m] = s;
    }
}
__device__ __forceinline__ void cache_rows(Frame& F, int l) {
    relane(F);
    bf16* KV = (bf16*)(F.ws + WS_R1 + R1_KV);
    const int gt = F.vcu * NWAVES * 64 + F.tid, NT_ = F.G * NWAVES * 64;
    for (int i = gt; i < 131072; i += NT_) {
        int which, q; if (i < 65536) { which = i >> 14; q = i & 16383; } else { which = 4 + ((i - 65536) >> 15); q = (i - 65536) & 32767; }
        const int pitch = which < 4 ? 128 : 256, per = 256 * pitch / 4;
        const int s = q / per, e = (q % per) * 4, p = e / pitch, c = e % pitch;
        const f32x4 v = *(const f32x4*)(F.in[2 + which] + ((size_t)(s * DEPTH + l) * 256 + p) * pitch + c);
        const long off = which == 0 ? pg8::KA_S : which == 1 ? pg8::VA_S : which == 2 ? pg8::KB_S : which == 3 ? pg8::VB_S : which == 4 ? pg8::KC_S : pg8::VC_S;
        *(GAS unsigned long long*)(KV + off + ((size_t)s * 4352 + p) * pitch + c) = (unsigned long long)pk2(v.x, v.y) | ((unsigned long long)pk2(v.z, v.w) << 32);
    }
}
constexpr int N_ATTN_UNITS = 768;
__device__ __forceinline__ void attn_phase(Frame& F, int l) {
    relane(F);
    bf16* QO = (bf16*)(F.ws + WS_R1 + R1_QO); const bf16* KV = (const bf16*)(F.ws + WS_R1 + R1_KV);
    float* scrb = (float*)(F.ws + WS_R2 + R2_SCR);
    const float lam = ((const float*)(F.ws + WS_LAM))[l]; const float lam_init = 0.8f - 0.6f * expf(-0.3f * (float)l);
    const float* sink = F.in[17] + l * 6; const float* gsub = F.in[22] + l * 64;
    gu32* qc = F.ctl + CW_QUEUE + 64 * l;
    char* shm = (char*)F.lds + RING_OFF;
    for (;;) {
        if (F.tid == 0) F.MISC[16] = __hip_atomic_fetch_add(qc, 1u, RLX_AGENT);
        __syncthreads();
        const int idx = __builtin_amdgcn_readfirstlane((int)F.MISC[16]);
        if (idx >= N_ATTN_UNITS) break;
        attn_body::AU a; a.scr = nullptr; a.lam = lam; a.gsub = gsub; a.sub_scale = 1.0f - lam_init; a.sink_l2 = 0.f; a.koff = 0; a.q0 = 0;
        int mix, smp, s, h, qb;
        if (idx < 128) { mix = 2; smp = 1; s = idx >> 6; h = (idx >> 4) & 3; qb = idx & 15; }
        else if (idx < 320) { const int j = idx - 128; mix = 0; smp = 1; s = j / 96; h = (j % 96) >> 4; qb = j & 15; }
        else if (idx < 512) { const int j = idx - 320; mix = 1; smp = 1; s = j / 96; h = (j % 96) >> 4; qb = j & 15; }
        else if (idx < 576) { const int j = idx - 512; mix = 2; smp = 0; s = j >> 2; h = j & 3; qb = 0; }
        else if (idx < 672) { const int j = idx - 576; mix = 0; smp = 0; s = j / 6; h = j % 6; qb = 0; }
        else { const int j = idx - 672; mix = 1; smp = 0; s = j / 6; h = j % 6; qb = 0; }
        const long row0 = smp ? NPROMPT + (long)s * 4096 + qb * 256 : (long)s * 256;
        const int kvh = (mix == 2) ? h : h / 3; const int pitch = (mix == 2) ? 256 : 128;
        const long koffs = smp ? (mix == 0 ? pg8::KA_S : mix == 1 ? pg8::KB_S : pg8::KC_S) : (mix == 0 ? pg8::KA_P : mix == 1 ? pg8::KB_P : pg8::KC_P);
        const long voffs = smp ? (mix == 0 ? pg8::VA_S : mix == 1 ? pg8::VB_S : pg8::VC_S) : (mix == 0 ? pg8::VA_P : mix == 1 ? pg8::VB_P : pg8::VC_P);
        const long seqrow = smp ? (long)s * 4352 : (long)s * 256;
        a.Q = (const attn_body::bf16*)(QO + row0 * 1024 + (mix == 0 ? 0 : mix == 1 ? 384 : 768) + h * 64); a.O = (attn_body::bf16*)a.Q;
        a.K = (const attn_body::bf16*)(KV + koffs + seqrow * pitch + kvh * 64); a.V = (const attn_body::bf16*)(KV + voffs + seqrow * pitch + kvh * 64); a.kvp = pitch;
        a.NT = smp ? 68 : 4; a.q0 = qb * 256;
        int npass = 1;
        if (mix == 2) { a.scr = scrb + ((size_t)h * NTOK + row0) * 64; a.mode = 2; npass = 2; }
        else { a.mode = (mix == 1) ? 1 : 0; if (mix == 1) a.sink_l2 = sink[h] * pg8::LOG2E; }
        if (mix == 1 && smp) {
            const int q0 = qb * 256, ks = (q0 - 128 > 0) ? q0 - 128 : 0, ke = (q0 + 384 < 4096) ? q0 + 384 : 4096;
            a.koff = ks; a.NT = 4 + (ke - ks) / 64;
            attn_body::attn_unit<8, true>(a, shm);
        } else {
#pragma unroll 1
            for (int ps = 0; ps < npass; ++ps) { attn_body::attn_unit<8, false>(a, shm); a.mode = 3; }
        }
    }
}
__device__ __forceinline__ void conv_phase(Frame& F, int l) {
    relane(F);
    const bf16* U = (const bf16*)(F.ws + WS_R1); bf16* ACT = (bf16*)(F.ws + WS_R2);
    const float* cw = F.in[25] + (size_t)l * 3 * DUP; const float* cb = F.in[26] + (size_t)l * DUP;
    if (F.tid >= 352) return;
    const int c0 = F.tid * 8;
    float w[2][3][8], b[2][8];
#pragma unroll
    for (int hf = 0; hf < 2; ++hf) {
#pragma unroll
        for (int k = 0; k < 3; ++k) { const f32x4 x0 = *(const f32x4*)(cw + k * DUP + hf * DFF + c0), x1 = *(const f32x4*)(cw + k * DUP + hf * DFF + c0 + 4);
#pragma unroll
            for (int j = 0; j < 4; ++j) { w[hf][k][j] = x0[j]; w[hf][k][4 + j] = x1[j]; } }
        const f32x4 y0 = *(const f32x4*)(cb + hf * DFF + c0), y1 = *(const f32x4*)(cb + hf * DFF + c0 + 4);
#pragma unroll
        for (int j = 0; j < 4; ++j) { b[hf][j] = y0[j]; b[hf][4 + j] = y1[j]; }
    }
    for (int strip = F.vcu; strip < NTOK / 48; strip += F.G) {
        const int r0 = strip * 48;
        v4u pa, pg, ca, cg, na, ng;
        if (r0 > 0) { pa = *(const GAS v4u*)(U + (size_t)(r0 - 1) * DUP + c0); pg = *(const GAS v4u*)(U + (size_t)(r0 - 1) * DUP + DFF + c0); } else { pa = (v4u){0u, 0u, 0u, 0u}; pg = pa; }
        ca = *(const GAS v4u*)(U + (size_t)r0 * DUP + c0); cg = *(const GAS v4u*)(U + (size_t)r0 * DUP + DFF + c0);
        for (int r = r0; r < r0 + 48; ++r) {
            const int t = (r < NPROMPT) ? (r & 255) : ((r - NPROMPT) & 4095), T = (r < NPROMPT) ? 256 : 4096;
            const float fp = (t > 0) ? 1.0f : 0.0f, fn = (t < T - 1) ? 1.0f : 0.0f;
            if (r + 1 < NTOK) { na = *(const GAS v4u*)(U + (size_t)(r + 1) * DUP + c0); ng = *(const GAS v4u*)(U + (size_t)(r + 1) * DUP + DFF + c0); } else { na = (v4u){0u, 0u, 0u, 0u}; ng = na; }
            v4u o;
#pragma unroll
            for (int q = 0; q < 4; ++q) {
                float res[2];
#pragma unroll
                for (int e = 0; e < 2; ++e) { const int j = 2 * q + e;
                    const float ap = e ? __uint_as_float(pa[q] & 0xffff0000u) : __uint_as_float(pa[q] << 16), ac = e ? __uint_as_float(ca[q] & 0xffff0000u) : __uint_as_float(ca[q] << 16), an = e ? __uint_as_float(na[q] & 0xffff0000u) : __uint_as_float(na[q] << 16);
                    const float gp = e ? __uint_as_float(pg[q] & 0xffff0000u) : __uint_as_float(pg[q] << 16), gc = e ? __uint_as_float(cg[q] & 0xffff0000u) : __uint_as_float(cg[q] << 16), gn = e ? __uint_as_float(ng[q] & 0xffff0000u) : __uint_as_float(ng[q] << 16);
                    const float av = w[0][0][j] * (fp * ap) + w[0][1][j] * ac + w[0][2][j] * (fn * an) + b[0][j];
                    const float gv = w[1][0][j] * (fp * gp) + w[1][1][j] * gc + w[1][2][j] * (fn * gn) + b[1][j];
                    res[e] = silu_f(av) * gv; }
                o[q] = pk2(res[0], res[1]);
            }
            *(GAS v4u*)(ACT + (size_t)r * DFF + c0) = o;
            pa = ca; pg = cg; ca = na; cg = ng;
        }
    }
}
__device__ __forceinline__ void final_phase(Frame& F) {
    relane(F);
    const float* ssq = (const float*)(F.ws + WS_CTL + CTL_SUMSQ) + 3 * (size_t)NTOK; const float* gf = F.in[28];
    const int gt = F.vcu * NWAVES * 64 + F.tid, NT_ = F.G * NWAVES * 64;
    for (int i = gt; i < NTOK * 256; i += NT_) { const int row = i >> 8, c = (i & 255) * 4;
        const float rstd = rsqrtf(ssq[row] * (1.0f / 1024.0f) + 1e-6f);
        f32x4* p = (f32x4*)(F.out + (size_t)row * DMODEL + c); *p = *p * rstd * (*(const f32x4*)(gf + c)); }
}

struct Args { const float* in[29]; float* out; unsigned char* ws; int ph_lo, ph_hi; };
__global__ void __launch_bounds__(NWAVES * 64, 2) fwd_kernel(const Args args) {
    extern __shared__ __attribute__((aligned(16))) unsigned char lds[];
    Frame F;
    F.lds = (LAS unsigned char*)lds; F.MISC = (volatile LAS unsigned*)(F.lds + MISC_OFF);
    F.tid = threadIdx.x; F.lane = F.tid & 63; F.wave = __builtin_amdgcn_readfirstlane(F.tid >> 6);
    F.G = gridDim.x; { const int bx = blockIdx.x; F.vcu = (F.G % 8 == 0) ? (bx % 8) * (F.G / 8) + bx / 8 : bx; }
    F.in = args.in;
    F.out = args.out; F.ws = args.ws; F.ctl = (gu32*)(args.ws + WS_CTL);
    for (int u = F.tid; u < (LDS_BYTES - LDSCTL_OFF) / 4; u += NWAVES * 64) ((LAS unsigned*)(F.lds + LDSCTL_OFF))[u] = 0u;
    __syncthreads();
    const int lo = args.ph_lo, hi = args.ph_hi;
    XcdBarrier bar; bar.bar = (unsigned*)(F.ctl + CW_BAR); bar.x = 0; bar.st = nullptr;
    if (hi - lo > 1) bar = xcd_barrier_post((unsigned*)(F.ctl + CW_BAR), F.MISC + 8);
#ifndef PH_MASK
#define PH_MASK 0xffffffffu
#endif
#define IN(k) (lo <= (k) && (k) < hi && ((PH_MASK >> (((k) < 2) ? (k) : (k) == N_PHASES - 1 ? 8 : 2 + ((k) - 2) % 6)) & 1u))
#define SEAM(k) do { if (IN(k) && IN((k) + 1)) xcd_barrier(bar); } while (0)
    unsigned char* ws = uni(args.ws); F.ws = ws; F.out = uni(args.out); F.ctl = (gu32*)(ws + WS_CTL);
    float* mod = (float*)(ws + WS_CTL + CTL_MOD); float* ssq = (float*)(ws + WS_CTL + CTL_SUMSQ);
    if (IN(0)) { p0a(F); } SEAM(0);
    if (IN(1)) { p0b(F); } SEAM(1);
#pragma unroll 1
    for (int l = 0; l < DEPTH; ++l) {
        const int pb = 2 + 6 * l;
        unsigned char* wl = ws + WS_W + l * W_LAYER;
        const float* ml = mod + (size_t)l * 3 * 6144;
        if (IN(pb)) {
            cache_rows(F, l);
            pg8::Gemm g{(const pg8::bf16_t*)(ws + WS_R1 + R1_H1), (const pg8::bf16_t*)(wl + W_IN_OFF), NTOK, DIN, DMODEL}; pg8::StaticOrder S; S.init(NTOK, DIN, F.G, (int)blockIdx.x);
            pg8::EpiIn E{l, l == 0 ? (const float*)(ws + WS_SS0) : ssq + (size_t)NTOK, (const float*)(ws + WS_CTL + CTL_CIN) + (size_t)l * 3 * DIN, F.in[15] + l * 64, F.in[16] + l * 64,
                         (const float*)(ws + WS_ROPE), (pg8::bf16_t*)(ws + WS_R1 + R1_QO), (pg8::bf16_t*)(ws + WS_R1 + R1_KV), F.out};
            pg8::gemm_phase<pg8::EpiIn, pg8::StaticOrder, true, true>(F.lds + RING_OFF, g, S, E);
        } SEAM(pb);
        if (IN(pb + 1)) { attn_phase(F, l); } SEAM(pb + 1);
        if (IN(pb + 2)) {
            pg8::Gemm g{(const pg8::bf16_t*)(ws + WS_R1 + R1_QO), (const pg8::bf16_t*)(wl + W_OUT_OFF), NTOK, DMODEL, DMODEL}; pg8::StaticOrder S; S.init(NTOK, DMODEL, F.G, (int)blockIdx.x);
            pg8::EpiRes E{l == 0 ? F.in[0] : F.out, l == 0 ? F.in[1] : F.out + (size_t)NPROMPT * DMODEL, F.out, ml + 2048, F.in[13] + l * DMODEL, ml + 4096,
                          (pg8::bf16_t*)(ws + WS_R2 + R2_H2), ssq + (size_t)(l == 0 ? 0 : 2) * NTOK};
            pg8::gemm_phase<pg8::EpiRes, pg8::StaticOrder, true, true>(F.lds + RING_OFF, g, S, E);
        } SEAM(pb + 2);
        if (IN(pb + 3)) {
            pg8::Gemm g{(const pg8::bf16_t*)(ws + WS_R2 + R2_H2), (const pg8::bf16_t*)(wl + W_UP_OFF), NTOK, DUP, DMODEL}; pg8::StaticOrder S; S.init(NTOK, DUP, F.G, (int)blockIdx.x);
            pg8::EpiUp E{ssq + (size_t)(l == 0 ? 0 : 2) * NTOK, (const float*)(ws + WS_CTL + CTL_CUP) + (size_t)l * 3 * DUP, (pg8::bf16_t*)(ws + WS_R1)};
            pg8::gemm_phase<pg8::EpiUp, pg8::StaticOrder, true, true>(F.lds + RING_OFF, g, S, E);
        } SEAM(pb + 3);
        if (IN(pb + 4)) { conv_phase(F, l); } SEAM(pb + 4);
        if (IN(pb + 5)) {
            pg8::Gemm g{(const pg8::bf16_t*)(ws + WS_R2), (const pg8::bf16_t*)(wl + W_DOWN_OFF), NTOK, DMODEL, DFF}; pg8::StaticOrder S; S.init(NTOK, DMODEL, F.G, (int)blockIdx.x);
            const bool more = (l + 1 < DEPTH);
            pg8::EpiRes E{F.out, F.out + (size_t)NPROMPT * DMODEL, F.out, ml + 5120, more ? F.in[12] + (l + 1) * DMODEL : nullptr, more ? ml + 3 * 6144 + 1024 : nullptr,
                          more ? (pg8::bf16_t*)(ws + WS_R1 + R1_H1) : nullptr, ssq + (size_t)(l == 0 ? 1 : 3) * NTOK};
            pg8::gemm_phase<pg8::EpiRes, pg8::StaticOrder, true, true>(F.lds + RING_OFF, g, S, E);
        } SEAM(pb + 5);
    }
    if (IN(N_PHASES - 1)) final_phase(F);
#undef IN
#undef SEAM
}

extern "C" void kernel_launch(void* const* d_in, const int* in_sizes, int n_in, void* d_out, int out_size, void* d_ws, size_t ws_size, hipStream_t stream) {
    static int grid = 0;
    if (grid == 0) {
        if (n_in != 29 || out_size != (int)pg8::O_TOTAL || ws_size < WS_END) { fprintf(stderr, "kernel_launch: unexpected shapes (n_in %d, out %d, ws %zu); nothing launched\n", n_in, out_size, ws_size); grid = -1; return; }
        int dev = 0, cus = 0, per_cu = 0;
        if (hipGetDevice(&dev) != hipSuccess || hipDeviceGetAttribute(&cus, hipDeviceAttributeMultiprocessorCount, dev) != hipSuccess) { grid = -1; return; }
        if (hipFuncSetAttribute((const void*)fwd_kernel, hipFuncAttributeMaxDynamicSharedMemorySize, LDS_BYTES) != hipSuccess) { fprintf(stderr, "kernel_launch: hipFuncSetAttribute failed\n"); grid = -1; return; }
        if (hipOccupancyMaxActiveBlocksPerMultiprocessor(&per_cu, (const void*)fwd_kernel, NWAVES * 64, LDS_BYTES) != hipSuccess || per_cu < 1) { fprintf(stderr, "kernel_launch: occupancy query reports %d blocks per CU\n", per_cu); }
        (void)hipGetLastError();
        grid = cus;
    }
    if (grid < 0) return;
    if (hipMemsetAsync((char*)d_ws + WS_CTL, 0, CTL_ZERO_BYTES, stream) != hipSuccess) return;
    Args a{};
    for (int i = 0; i < 29; ++i) a.in[i] = (const float*)d_in[i];
    a.out = (float*)d_out; a.ws = (unsigned char*)d_ws;
    if (MK_N_LAUNCHES == 1) { a.ph_lo = 0; a.ph_hi = N_PHASES; hipLaunchKernelGGL(fwd_kernel, dim3(grid), dim3(NWAVES * 64), LDS_BYTES, stream, a); }
    else for (int p = 0; p < N_PHASES; ++p) { a.ph_lo = p; a.ph_hi = p + 1; hipLaunchKernelGGL(fwd_kernel, dim3(grid), dim3(NWAVES * 64), LDS_BYTES, stream, a); }
}
```

```cpp
#ifndef MK_N_LAUNCHES
#define MK_N_LAUNCHES 1
#endif
#include <hip/hip_runtime.h>
#include <cstdio>
#include <cstdint>
namespace pg8 {
#define PG8_LAS __attribute__((address_space(3)))
typedef unsigned short bf16_t;
typedef short bf16x8 __attribute__((ext_vector_type(8)));
typedef float f32x4 __attribute__((ext_vector_type(4)));
typedef unsigned u32x4 __attribute__((ext_vector_type(4)));
constexpr int BM = 256, BK = 64, HALF = 128, HTB = HALF * BK * 2  , STAGE_BYTES = 8 * HTB, NXCD = 8, WGM = 8;

__host__ __device__ __forceinline__ int lds_byte(int r, int c) { const int st = (r >> 4) * 2 + (c >> 5), rr = r & 15, cc = c & 31, ob = rr * 64 + cc * 2; return st * 1024 + (ob ^ (((ob >> 9) & 1) << 5)); }
__host__ __device__ __forceinline__ void stage_rc(int b, int& R, int& C) { const int st = b / 1024, sb = b % 1024, swz = sb ^ (((sb >> 9) & 1) << 5); R = (st >> 1) * 16 + swz / 64; C = (st & 1) * 32 + (swz % 64) / 2; }
__host__ __device__ __forceinline__ int perm32(int rho) { const int n = rho >> 4, i = rho & 15; return 8 * (i >> 2) + 4 * n + (i & 3); }

struct Unit { int pm, pn; };
struct Gemm { const bf16_t* A; const bf16_t* Bt; int M, N, K; };

struct StaticOrder {
    int nM, nN, nwg, G, c;
    __host__ __device__ void init(int M, int N, int G_, int c_) { nM = M / BM; nN = N / BM; nwg = nM * nN; G = G_; c = c_; }
    __host__ __device__ bool next(int i, Unit& u) const {
        const long L = (long)i * G + c; if (L >= nwg) return false;
        int wgid = (int)L; { const int q = nwg / NXCD, r = nwg % NXCD, xcd = wgid % NXCD, off = wgid / NXCD; wgid = (xcd < r ? xcd * (q + 1) : r * (q + 1) + (xcd - r) * q) + off; }
        const int nig = WGM * nN, gid = wgid / nig, fm = gid * WGM, gsz = (nM - fm) < WGM ? (nM - fm) : WGM;
        u.pm = fm + ((wgid % nig) % gsz); u.pn = (wgid % nig) / gsz; return true;
    }
    __device__ __forceinline__ void a_ready(const Unit&) const {}
    __device__ __forceinline__ void done(const Unit&) const {}
};
__device__ __forceinline__ unsigned cvt_pk_bf16(float lo, float hi) { unsigned r; asm volatile("v_cvt_pk_bf16_f32 %0, %1, %2" : "=v"(r) : "v"(lo), "v"(hi)); return r; }
typedef unsigned u32x2 __attribute__((ext_vector_type(2)));
constexpr float RMS_EPS = 1e-6f, LOG2E = 1.4426950408889634f;
constexpr float C2_64 = 0.125f * LOG2E, C2_32 = 0.17677669529663687f * LOG2E;
constexpr int NTOK = 12288, NPROMPT = 4096;
constexpr long KA_S = 0, VA_S = 1114112, KB_S = 2228224, VB_S = 3342336, KC_S = 4456448, VC_S = 6684672,
               KA_P = 8912896, VA_P = 9437184, KB_P = 9961472, VB_P = 10485760, KC_P = 11010048, VC_P = 12058624, KV_ELEMS = 13107200;
constexpr long O_NAK = 12582912, O_NAV = 13631488, O_NBK = 14680064, O_NBV = 15728640, O_NCK = 16777216, O_NCV = 18874368, O_TOTAL = 20971520;

struct EpiIn {
    static constexpr bool PERM = false, AFTER_DRAIN = false;
    int layer; const float* sumsq; const float* cin; const float* gqa; const float* gka; const float* rope; bf16_t* Q; bf16_t* KV; float* out;
    __device__ __forceinline__ void operator()(const f32x4 (&acc)[2][2][4][2], const Unit& u, int wr, int wc, int fr, int fq) const {
        const int g = u.pn * 4 + wc;
        const bool smp = u.pm >= 16;
        const int sq = smp ? ((u.pm - 16) >> 4) : u.pm;
        const int t0 = smp ? ((u.pm - 16) & 15) * 256 : 0;
        const int cond = smp ? 1 + sq : 0;
        int mix, kind, hh;
        if (g < 6) { mix = 0; kind = 0; hh = g; } else if (g < 8) { mix = 0; kind = 1; hh = g - 6; } else if (g < 10) { mix = 0; kind = 2; hh = g - 8; }
        else if (g < 16) { mix = 1; kind = 0; hh = g - 10; } else if (g < 18) { mix = 1; kind = 1; hh = g - 16; } else if (g < 20) { mix = 1; kind = 2; hh = g - 18; }
        else if (g < 24) { mix = 2; kind = 0; hh = g - 20; } else if (g < 28) { mix = 2; kind = 1; hh = g - 24; } else { mix = 2; kind = 2; hh = g - 28; }
        const bool c32 = (mix == 2) && (kind != 2);
        const int nst = c32 ? 8 : 16;
        const int dlo = c32 ? (16 * (fq >> 1) + 4 * (fq & 1)) : 4 * fq;
        bf16_t* dst; long dpitch, drow0; float* fo = nullptr; long forow0 = 0;
        if (kind == 0) { dst = Q + (mix == 0 ? 0 : mix == 1 ? 384 : 768) + hh * 64; dpitch = 1024; drow0 = (long)u.pm * 256; }
        else {
            dpitch = (mix == 2) ? 256 : 128;
            long off;
            if (smp) { off = mix == 0 ? (kind == 1 ? KA_S : VA_S) : mix == 1 ? (kind == 1 ? KB_S : VB_S) : (kind == 1 ? KC_S : VC_S); drow0 = (long)sq * 4352 + 256 + t0; }
            else { off = mix == 0 ? (kind == 1 ? KA_P : VA_P) : mix == 1 ? (kind == 1 ? KB_P : VB_P) : (kind == 1 ? KC_P : VC_P); drow0 = (long)sq * 256;
                   fo = out + (mix == 0 ? (kind == 1 ? O_NAK : O_NAV) : mix == 1 ? (kind == 1 ? O_NBK : O_NBV) : (kind == 1 ? O_NCK : O_NCV)) + hh * 64; forow0 = ((long)sq * 2 + layer) * 256; }
            dst = KV + off + hh * 64;
        }
        const bool nrm = (mix == 0) && (kind < 2);
        const bool rp = smp && (kind < 2);
        const float qs = (kind == 0) ? (mix == 2 ? C2_32 : C2_64) : 1.0f;
        f32x4 cv[2][2];
        const float* cp = cin + cond * 2048 + g * 64 + dlo;
        const float* gp = ((kind == 0) ? gqa : gka) + 4 * fq;
#pragma unroll
        for (int bj = 0; bj < 2; ++bj)
#pragma unroll
            for (int n = 0; n < 2; ++n) cv[bj][n] = *(const f32x4*)(cp + 32 * bj + nst * n);
        const float* ssp = sumsq + u.pm * BM + wr * 64 + fr;
        bf16_t* dstb = dst + (drow0 + wr * 64 + fr) * dpitch + dlo;
        float* fob = fo ? fo + (forow0 + wr * 64 + fr) * dpitch + dlo : nullptr;
        const float* rrow = c32 ? rope + 2048 + ((t0 >> 6) + wr) * 8 + 4 * (fq & 1) : rope + ((t0 >> 6) + wr) * 16 + 4 * fq;
        const float* rcol = c32 ? rope + 2048 + fr * 8 + 4 * (fq & 1) : rope + fr * 16 + 4 * fq;
        const int rst = c32 ? 8 : 16, sof = c32 ? 512 : 1024;
#pragma unroll
        for (int ai = 0; ai < 2; ++ai)
#pragma unroll
            for (int m = 0; m < 4; ++m) {
                const float rstd = rsqrtf(ssp[ai * HALF + m * 16] * (1.0f / 1024.0f) + RMS_EPS);
                f32x4 v[2][2];
#pragma unroll
                for (int bj = 0; bj < 2; ++bj)
#pragma unroll
                    for (int n = 0; n < 2; ++n) v[bj][n] = acc[ai][bj][m][n] * rstd + cv[bj][n];
                if (nrm) {
                    float ss = 0.f;
#pragma unroll
                    for (int bj = 0; bj < 2; ++bj)
#pragma unroll
                        for (int n = 0; n < 2; ++n) { const f32x4 x = v[bj][n]; ss += (x[0] * x[0] + x[1] * x[1]) + (x[2] * x[2] + x[3] * x[3]); }
                    ss += __shfl_xor(ss, 16); ss += __shfl_xor(ss, 32);
                    const float rn = rsqrtf(ss * (1.0f / 64.0f) + RMS_EPS);
#pragma unroll
                    for (int bj = 0; bj < 2; ++bj)
#pragma unroll
                        for (int n = 0; n < 2; ++n) v[bj][n] = v[bj][n] * rn * (*(const f32x4*)(gp + 32 * bj + 16 * n));
                }
                if (fo) {
#pragma unroll
                    for (int bj = 0; bj < 2; ++bj)
#pragma unroll
                        for (int n = 0; n < 2; ++n) *(f32x4*)(fob + (long)(ai * HALF + m * 16) * dpitch + 32 * bj + nst * n) = v[bj][n];
                }
                if (rp) {
#pragma unroll
                    for (int bj = 0; bj < 2; ++bj) {
                        const bool colpart = c32 ? (fq >> 1) != 0 : (bj != 0);
                        const float* cs = colpart ? rcol + m * 16 * rst : rrow + 2 * ai * rst;
                        const f32x4 c = *(const f32x4*)cs, sn = *(const f32x4*)(cs + sof);
                        const f32x4 x1 = v[bj][0], x2 = v[bj][1];
                        v[bj][0] = x1 * c - x2 * sn; v[bj][1] = x2 * c + x1 * sn;
                    }
                }
#pragma unroll
                for (int bj = 0; bj < 2; ++bj)
#pragma unroll
                    for (int n = 0; n < 2; ++n) { const f32x4 w = v[bj][n] * qs; u32x2 pk; pk.x = cvt_pk_bf16(w[0], w[1]); pk.y = cvt_pk_bf16(w[2], w[3]);
                        *(u32x2*)(dstb + (long)(ai * HALF + m * 16) * dpitch + 32 * bj + nst * n) = pk; }
                asm volatile("" ::: "memory");
            }
    }
};

struct EpiRes {
    static constexpr bool PERM = false, AFTER_DRAIN = false;
    const float* src_p; const float* src_s; float* X; const float* gate; const float* gn; const float* scn; bf16_t* H; float* sumsq;
    __device__ __forceinline__ void operator()(const f32x4 (&acc)[2][2][4][2], const Unit& u, int wr, int wc, int fr, int fq) const {
        const bool smp = u.pm >= 16; const int cond = smp ? 1 + ((u.pm - 16) >> 4) : 0;
        const float* src = smp ? src_s + ((long)u.pm * BM - NPROMPT) * 1024 : src_p + (long)u.pm * BM * 1024;
        float* xo = X + (long)u.pm * BM * 1024; bf16_t* ho = H ? H + (long)u.pm * BM * 1024 : nullptr;
        const int col0 = u.pn * BM + wc * 32 + 4 * fq;
        f32x4 gt[2][2], gm[2][2];
#pragma unroll
        for (int bj = 0; bj < 2; ++bj)
#pragma unroll
            for (int n = 0; n < 2; ++n) { const int c = col0 + bj * HALF + n * 16; gt[bj][n] = *(const f32x4*)(gate + cond * 6144 + c);
                gm[bj][n] = H ? *(const f32x4*)(gn + c) * (*(const f32x4*)(scn + cond * 6144 + c) + 1.0f) : (f32x4){0.f, 0.f, 0.f, 0.f}; }
#pragma unroll
        for (int ai = 0; ai < 2; ++ai)
#pragma unroll
            for (int m = 0; m < 4; ++m) {
                const int rloc = ai * HALF + wr * 64 + m * 16 + fr; float ss = 0.f;
#pragma unroll
                for (int bj = 0; bj < 2; ++bj)
#pragma unroll
                    for (int n = 0; n < 2; ++n) { const long off = (long)rloc * 1024 + col0 + bj * HALF + n * 16;
                        const f32x4 x1 = *(const f32x4*)(src + off) + gt[bj][n] * acc[ai][bj][m][n]; *(f32x4*)(xo + off) = x1;
                        ss += (x1[0] * x1[0] + x1[1] * x1[1]) + (x1[2] * x1[2] + x1[3] * x1[3]);
                        if (H) { const f32x4 w = x1 * gm[bj][n]; u32x2 pk; pk.x = cvt_pk_bf16(w[0], w[1]); pk.y = cvt_pk_bf16(w[2], w[3]); *(u32x2*)(ho + off) = pk; } }
                ss += __shfl_xor(ss, 16); ss += __shfl_xor(ss, 32);
                if (fq == 0) unsafeAtomicAdd(sumsq + u.pm * BM + rloc, ss);
            }
    }
};

struct EpiUp {
    static constexpr bool PERM = false, AFTER_DRAIN = false;
    const float* sumsq; const float* cup; bf16_t* U;
    __device__ __forceinline__ void operator()(const f32x4 (&acc)[2][2][4][2], const Unit& u, int wr, int wc, int fr, int fq) const {
        const bool smp = u.pm >= 16; const int cond = smp ? 1 + ((u.pm - 16) >> 4) : 0;
        const int col0 = u.pn * BM + wc * 32 + 8 * fq;
        f32x4 cv[2][2];
#pragma unroll
        for (int bj = 0; bj < 2; ++bj)
#pragma unroll
            for (int n = 0; n < 2; ++n) cv[bj][n] = *(const f32x4*)(cup + cond * 5632 + col0 + bj * HALF + 4 * n);
#pragma unroll
        for (int ai = 0; ai < 2; ++ai)
#pragma unroll
            for (int m = 0; m < 4; ++m) {
                const int rloc = ai * HALF + wr * 64 + m * 16 + fr; const long row = (long)u.pm * BM + rloc;
                const float rstd = rsqrtf(sumsq[row] * (1.0f / 1024.0f) + RMS_EPS);
#pragma unroll
                for (int bj = 0; bj < 2; ++bj) { const f32x4 v0 = acc[ai][bj][m][0] * rstd + cv[bj][0], v1 = acc[ai][bj][m][1] * rstd + cv[bj][1];
                    u32x4 w; w.x = cvt_pk_bf16(v0[0], v0[1]); w.y = cvt_pk_bf16(v0[2], v0[3]); w.z = cvt_pk_bf16(v1[0], v1[1]); w.w = cvt_pk_bf16(v1[2], v1[3]);
                    *(u32x4*)(U + row * 5632 + col0 + bj * HALF) = w; }
            }
    }
};

template <class Epi, class Sched, bool ALIGN_EPI = false, bool SP2 = false>
__device__ __forceinline__ void gemm_phase(PG8_LAS unsigned char* lds, const Gemm g, const Sched& S, const Epi& E) {
    int tid_ = threadIdx.x; asm volatile("" : "+v"(tid_));
    const int tid = tid_, wid = __builtin_amdgcn_readfirstlane(tid >> 6), lane = tid & 63, wr = wid >> 2, wc = wid & 3, fr = lane & 15, fq = lane >> 4;
    const int K = g.K, nt = K / BK;
    unsigned voffA[2], voffB[2];
#pragma unroll
    for (int i = 0; i < 2; ++i) { int R, C; stage_rc(tid * 16 + i * 8192, R, C); const int Rb = Epi::PERM ? ((R & ~31) + perm32(R & 31)) : R;
        voffA[i] = (unsigned)(R * K + C) * 2u; voffB[i] = (unsigned)(Rb * K + C) * 2u; }
    const size_t kstep = (size_t)(BK * 2);
    const size_t hstep = (size_t)HALF * K * 2;
    const size_t tstep = 2 * hstep;
    const unsigned ldsw = (unsigned)wid * 1024u;
    const int aoff = lds_byte(wr * 64 + fr, fq * 8), boff = lds_byte(wc * 32 + fr, fq * 8);
#define PG8_SA(b, h) (((b) * 2 + (h)) * HTB)
#define PG8_SB(b, h) ((4 + (b) * 2 + (h)) * HTB)
#define PG8_STAGE(bufoff, gbase, voff) do { _Pragma("unroll") for (int _i = 0; _i < 2; ++_i) \
        __builtin_amdgcn_global_load_lds((const unsigned*)((const char*)(gbase) + (voff)[_i]), (PG8_LAS unsigned*)(lds + (bufoff) + ldsw + _i * 8192), 16, 0, 0); } while (0)
#define PG8_LDA(dst, b, h) do { _Pragma("unroll") for (int m = 0; m < 4; ++m) _Pragma("unroll") for (int k = 0; k < 2; ++k) dst[m][k] = *(const PG8_LAS bf16x8*)(lds + PG8_SA(b, h) + aoff + m * 2048 + k * 1024); } while (0)
#define PG8_LDB(dst, b, h) do { _Pragma("unroll") for (int n = 0; n < 2; ++n) _Pragma("unroll") for (int k = 0; k < 2; ++k) dst[n][k] = *(const PG8_LAS bf16x8*)(lds + PG8_SB(b, h) + boff + n * 2048 + k * 1024); } while (0)
#define PG8_MMA(ai, bj, At, Bt) do { __builtin_amdgcn_s_setprio(1); _Pragma("unroll") for (int m = 0; m < 4; ++m) _Pragma("unroll") for (int n = 0; n < 2; ++n) _Pragma("unroll") for (int k = 0; k < 2; ++k) \
        acc[ai][bj][m][n] = __builtin_amdgcn_mfma_f32_16x16x32_bf16(Bt[n][k], At[m][k], acc[ai][bj][m][n], 0, 0, 0); __builtin_amdgcn_s_setprio(0); } while (0)
#define PG8_WAIT_V(n) asm volatile("s_waitcnt vmcnt(" #n ")" ::: "memory")
#define PG8_WAIT_L(n) asm volatile("s_waitcnt lgkmcnt(" #n ")" ::: "memory")
#define PG8_BAR __builtin_amdgcn_s_barrier()
#define PG8_SCHED __builtin_amdgcn_sched_barrier(0)
    Unit cur, nxt; int ui = 0;
    if (!S.next(0, cur)) return;
    f32x4 acc[2][2][4][2];
#pragma unroll
    for (int a = 0; a < 2; ++a)
#pragma unroll
        for (int b = 0; b < 2; ++b)
#pragma unroll
            for (int m = 0; m < 4; ++m)
#pragma unroll
                for (int n = 0; n < 2; ++n) acc[a][b][m][n] = (f32x4){0.f, 0.f, 0.f, 0.f};
    bf16x8 At[4][2], B0[2][2], B1[2][2];
    const char* cA = (const char*)g.A + (size_t)cur.pm * tstep; const char* cB = (const char*)g.Bt + (size_t)cur.pn * tstep;
    S.a_ready(cur);
    if constexpr (SP2) {
        PG8_STAGE(PG8_SB(0, 0), cB, voffB); PG8_STAGE(PG8_SB(0, 1), cB + hstep, voffB); PG8_STAGE(PG8_SA(0, 0), cA, voffA); PG8_STAGE(PG8_SA(0, 1), cA + hstep, voffA);
        if (wr == 1) PG8_BAR;
        PG8_WAIT_V(2); PG8_BAR;
        PG8_STAGE(PG8_SB(1, 0), cB + kstep, voffB); PG8_STAGE(PG8_SA(1, 0), cA + kstep, voffA); PG8_STAGE(PG8_SB(1, 1), cB + hstep + kstep, voffB);
        PG8_WAIT_V(6); PG8_BAR;
    } else {
        PG8_STAGE(PG8_SB(0, 0), cB, voffB); PG8_STAGE(PG8_SA(0, 0), cA, voffA); PG8_STAGE(PG8_SB(0, 1), cB + hstep, voffB); PG8_STAGE(PG8_SA(0, 1), cA + hstep, voffA);
        if (wr == 1) PG8_BAR;
        PG8_WAIT_V(4); PG8_BAR;
        PG8_STAGE(PG8_SB(1, 0), cB + kstep, voffB); PG8_STAGE(PG8_SA(1, 0), cA + kstep, voffA); PG8_STAGE(PG8_SB(1, 1), cB + hstep + kstep, voffB);
        PG8_WAIT_V(6); PG8_BAR;
    }
    for (;;) {
        const bool has_next = S.next(ui + 1, nxt);
        const char* nA = has_next ? (const char*)g.A + (size_t)nxt.pm * tstep : cA; const char* nB = has_next ? (const char*)g.Bt + (size_t)nxt.pn * tstep : cB;
        for (int t = 0; t < nt; t += 2) {
            const bool last = (t == nt - 2);
            const char* a1 = cA + (size_t)(t + 1) * kstep;
            const char* a2 = last ? nA : cA + (size_t)(t + 2) * kstep; const char* b2 = last ? nB : cB + (size_t)(t + 2) * kstep;
            const char* a3 = a2 + kstep; const char* b3 = b2 + kstep;
            if (last && has_next) S.a_ready(nxt);
            if constexpr (SP2) {
            PG8_LDB(B0, 0, 0); PG8_LDB(B1, 0, 1); PG8_SCHED; PG8_LDA(At, 0, 0); PG8_STAGE(PG8_SA(1, 1), a1 + hstep, voffA);
            PG8_WAIT_V(8); PG8_WAIT_L(0); PG8_BAR; PG8_MMA(0, 0, At, B0); PG8_MMA(0, 1, At, B1); PG8_BAR; PG8_SCHED;
            PG8_LDA(At, 0, 1); PG8_STAGE(PG8_SB(0, 0), b2, voffB); PG8_STAGE(PG8_SB(0, 1), b2 + hstep, voffB); PG8_STAGE(PG8_SA(0, 0), a2, voffA);
            PG8_WAIT_V(8); PG8_WAIT_L(0); PG8_BAR; PG8_MMA(1, 0, At, B0); PG8_MMA(1, 1, At, B1); PG8_BAR; PG8_SCHED;
            PG8_LDB(B0, 1, 0); PG8_LDB(B1, 1, 1); PG8_SCHED; PG8_LDA(At, 1, 0); PG8_STAGE(PG8_SA(0, 1), a2 + hstep, voffA);
            PG8_WAIT_V(8); PG8_WAIT_L(0); PG8_BAR; PG8_MMA(0, 0, At, B0); PG8_MMA(0, 1, At, B1); PG8_BAR; PG8_SCHED;
            PG8_LDA(At, 1, 1); PG8_STAGE(PG8_SB(1, 0), b3, voffB); PG8_STAGE(PG8_SB(1, 1), b3 + hstep, voffB); PG8_STAGE(PG8_SA(1, 0), a3, voffA);
            PG8_WAIT_V(8); PG8_WAIT_L(0); PG8_BAR; PG8_MMA(1, 0, At, B0); PG8_MMA(1, 1, At, B1); PG8_BAR; PG8_SCHED;
            } else {
            PG8_LDB(B0, 0, 0); PG8_SCHED; PG8_LDA(At, 0, 0); PG8_STAGE(PG8_SA(1, 1), a1 + hstep, voffA);
            PG8_WAIT_L(8); PG8_BAR; PG8_WAIT_L(0); PG8_MMA(0, 0, At, B0); PG8_BAR; PG8_SCHED;
            PG8_LDB(B1, 0, 1); PG8_STAGE(PG8_SB(0, 0), b2, voffB);
            PG8_BAR; PG8_WAIT_L(0); PG8_MMA(0, 1, At, B1); PG8_BAR;
            PG8_LDA(At, 0, 1); PG8_STAGE(PG8_SA(0, 0), a2, voffA);
            PG8_BAR; PG8_WAIT_L(0); PG8_MMA(1, 0, At, B0); PG8_BAR; PG8_SCHED;
            PG8_STAGE(PG8_SB(0, 1), b2 + hstep, voffB);
            PG8_WAIT_V(6); PG8_BAR; PG8_MMA(1, 1, At, B1); PG8_BAR;
            PG8_LDB(B0, 1, 0); PG8_SCHED; PG8_LDA(At, 1, 0); PG8_STAGE(PG8_SA(0, 1), a2 + hstep, voffA);
            PG8_WAIT_L(8); PG8_BAR; PG8_WAIT_L(0); PG8_MMA(0, 0, At, B0); PG8_BAR; PG8_SCHED;
            PG8_LDB(B1, 1, 1); PG8_STAGE(PG8_SB(1, 0), b3, voffB);
            PG8_BAR; PG8_WAIT_L(0); PG8_MMA(0, 1, At, B1); PG8_BAR;
            PG8_LDA(At, 1, 1); PG8_STAGE(PG8_SA(1, 0), a3, voffA);
            PG8_BAR; PG8_WAIT_L(0); PG8_MMA(1, 0, At, B0); PG8_BAR; PG8_SCHED;
            PG8_STAGE(PG8_SB(1, 1), b3 + hstep, voffB);
            PG8_WAIT_V(6); PG8_BAR; PG8_MMA(1, 1, At, B1); PG8_BAR;
            }
        }
        if constexpr (ALIGN_EPI) { if (wr == 0) PG8_BAR; }
        if constexpr (!Epi::AFTER_DRAIN) { E(acc, cur, wr, wc, fr, fq); S.done(cur); }
        if (!has_next) break;
#pragma unroll
        for (int a = 0; a < 2; ++a)
#pragma unroll
            for (int b = 0; b < 2; ++b)
#pragma unroll
                for (int m = 0; m < 4; ++m)
#pragma unroll
                    for (int n = 0; n < 2; ++n) acc[a][b][m][n] = (f32x4){0.f, 0.f, 0.f, 0.f};
        cur = nxt; cA = nA; cB = nB; ++ui;
        if constexpr (ALIGN_EPI) { if (wr == 1) PG8_BAR; }
    }
    PG8_WAIT_V(0);
    if constexpr (!ALIGN_EPI) { if (wr == 0) PG8_BAR; }
    PG8_BAR;
    if constexpr (Epi::AFTER_DRAIN) { E.fused(acc, cur, wr, wc, fr, fq, lds, wid, lane); S.done(cur); }
#undef PG8_SA
#undef PG8_SB
#undef PG8_STAGE
#undef PG8_LDA
#undef PG8_LDB
#undef PG8_MMA
#undef PG8_WAIT_V
#undef PG8_WAIT_L
#undef PG8_BAR
#undef PG8_SCHED
}
}
#include <hip/hip_bf16.h>
#include <cmath>
namespace attn_body {
using bf16=__hip_bfloat16;
using bf16x8=__attribute__((ext_vector_type(8)))short;
using s16x4=__attribute__((ext_vector_type(4)))short;
using f32x16=__attribute__((ext_vector_type(16)))float;
using u32x4=__attribute__((ext_vector_type(4)))unsigned;
using f32x4=__attribute__((ext_vector_type(4)))float;
using u32x2=__attribute__((ext_vector_type(2)))unsigned;
constexpr int D=64,QP=1024;
constexpr int NW=8,QBLK=32,QB=QBLK*NW,KVBLK=64;
__device__ __forceinline__ int crow(int r,int hi){return (r&3)+8*(r>>2)+4*hi;}
#define SBAR() __builtin_amdgcn_sched_barrier(0)
__device__ __forceinline__ void bmask(f32x16&p0,f32x16&p1,int dlt,int hi){
  const float NEG=-INFINITY; const int kb=dlt+4*hi;
  #pragma unroll
  for(int r=0;r<16;++r){const int kv=kb+(r&3)+8*(r>>2); if(kv>128||kv<-128)p0[r]=NEG; if(kv+32>128||kv+32<-128)p1[r]=NEG;}
}

constexpr int NSLOT=3, SLOTB=8192;
constexpr int LDS_K=0, LDS_V=NSLOT*SLOTB, LDS_WS=2*NSLOT*SLOTB, LDS_OST=LDS_WS+NW*64*4, LDS_BYTES=LDS_OST+NW*8192;
__device__ __forceinline__ void glds16(const void*gsrc,unsigned lds_dst){unsigned keep;
  asm volatile("s_mov_b32 %0, m0\n\ts_mov_b32 m0, %2\n\ts_nop 0\n\tglobal_load_lds_dwordx4 %1, off\n\ts_mov_b32 m0, %0":"=&s"(keep):"v"(gsrc),"s"(lds_dst):"memory");}
__device__ __forceinline__ float max3f(float a,float b,float c){float r;asm("v_max3_f32 %0, %1, %2, %3":"=v"(r):"v"(a),"v"(b),"v"(c));return r;}
__device__ __forceinline__ float max2f(float a,float b){float r;asm("v_max_f32_e32 %0, %1, %2":"=v"(r):"v"(a),"v"(b));return r;}
__device__ __forceinline__ float fadd_s(float a,float b){float r;asm("v_add_f32_e32 %0, %1, %2":"=v"(r):"v"(a),"v"(b));return r;}
__device__ __forceinline__ float fsub_s(float a,float b){float r;asm("v_sub_f32_e32 %0, %1, %2":"=v"(r):"v"(a),"v"(b));return r;}
typedef float f32x2_t __attribute__((ext_vector_type(2))); typedef __bf16 bf16x2_t __attribute__((ext_vector_type(2)));
__device__ __forceinline__ unsigned cvtpk_s(float lo,float hi){f32x2_t v={lo,hi};bf16x2_t b=__builtin_convertvector(v,bf16x2_t);return __builtin_bit_cast(unsigned,b);}
#define WAIT_BAR(N) asm volatile("s_waitcnt vmcnt(" #N ") lgkmcnt(0)\n\ts_barrier":::"memory")

__device__ __forceinline__ void qkt(f32x16&p0,f32x16&p1,const char*Kslot,const bf16x8*qr,const f32x16&negm,int r32,int hi){
  const char*kb=Kslot+hi*1024+r32*16;
  #pragma unroll
  for(int d0=0;d0<4;++d0){
    const bf16x8 b0=*reinterpret_cast<const bf16x8*>(kb+d0*2048);
    const bf16x8 b1=*reinterpret_cast<const bf16x8*>(kb+d0*2048+512);
    if(d0==0){p0=__builtin_amdgcn_mfma_f32_32x32x16_bf16(b0,qr[0],negm,0,0,0);p1=__builtin_amdgcn_mfma_f32_32x32x16_bf16(b1,qr[0],negm,0,0,0);}
    else{p0=__builtin_amdgcn_mfma_f32_32x32x16_bf16(b0,qr[d0],p0,0,0,0);p1=__builtin_amdgcn_mfma_f32_32x32x16_bf16(b1,qr[d0],p1,0,0,0);}}
}
typedef __attribute__((address_space(3))) const char* lds_cptr;
typedef short v4i16_t __attribute__((ext_vector_type(4)));
__device__ __forceinline__ void kload8(bf16x8*kf,lds_cptr kp){
  kf[0]=*(const __attribute__((address_space(3))) bf16x8*)(kp);      kf[1]=*(const __attribute__((address_space(3))) bf16x8*)(kp+512);
  kf[2]=*(const __attribute__((address_space(3))) bf16x8*)(kp+2048); kf[3]=*(const __attribute__((address_space(3))) bf16x8*)(kp+2560);
  kf[4]=*(const __attribute__((address_space(3))) bf16x8*)(kp+4096); kf[5]=*(const __attribute__((address_space(3))) bf16x8*)(kp+4608);
  kf[6]=*(const __attribute__((address_space(3))) bf16x8*)(kp+6144); kf[7]=*(const __attribute__((address_space(3))) bf16x8*)(kp+6656);
}
__device__ __forceinline__ void kload2(bf16x8*kf,lds_cptr kp,int j){ kf[2*j]=*(const __attribute__((address_space(3))) bf16x8*)(kp+j*2048); kf[2*j+1]=*(const __attribute__((address_space(3))) bf16x8*)(kp+j*2048+512); }
__device__ __forceinline__ s16x4 vtr(lds_cptr p){ return __builtin_bit_cast(s16x4,__builtin_amdgcn_ds_read_tr16_b64_v4i16((__attribute__((address_space(3))) v4i16_t*)p)); }
__device__ __forceinline__ float rowmax(const f32x16&p0,const f32x16&p1){
  float a=max3f(p0[0],p0[1],p1[0]),b=max3f(p0[2],p0[3],p1[1]);a=max3f(a,p1[2],p1[3]);
  #pragma unroll
  for(int r=4;r<16;r+=4){a=max3f(a,p0[r],p0[r+1]);b=max3f(b,p0[r+2],p0[r+3]);a=max3f(a,p1[r],p1[r+1]);b=max3f(b,p1[r+2],p1[r+3]);}
  const float m=max2f(a,b);
  auto rr=__builtin_amdgcn_permlane32_swap(__float_as_uint(m),__float_as_uint(m),false,false);
  return max2f(__uint_as_float(rr[0]),__uint_as_float(rr[1]));
}
__device__ __forceinline__ void pv(f32x16*o,int vb,bf16x8 pa0,bf16x8 pa1,bf16x8 pa2,bf16x8 pa3){
  #pragma unroll
  for(int d0=0;d0<2;++d0){s16x4 lo[4],hi[4];
    #pragma unroll
    for(int ks=0;ks<4;++ks){
      asm volatile("ds_read_b64_tr_b16 %0,%1 offset:%c2":"=&v"(lo[ks]):"v"(vb),"i"(d0*4096+ks*1024):"memory");
      asm volatile("ds_read_b64_tr_b16 %0,%1 offset:%c2":"=&v"(hi[ks]):"v"(vb),"i"(d0*4096+ks*1024+512):"memory");}
    asm volatile("s_waitcnt lgkmcnt(0)":::"memory");SBAR();
    #define PK(k) (bf16x8){lo[k][0],lo[k][1],lo[k][2],lo[k][3],hi[k][0],hi[k][1],hi[k][2],hi[k][3]}
    o[d0]=__builtin_amdgcn_mfma_f32_32x32x16_bf16(pa0,PK(0),o[d0],0,0,0);
    o[d0]=__builtin_amdgcn_mfma_f32_32x32x16_bf16(pa1,PK(1),o[d0],0,0,0);
    o[d0]=__builtin_amdgcn_mfma_f32_32x32x16_bf16(pa2,PK(2),o[d0],0,0,0);
    o[d0]=__builtin_amdgcn_mfma_f32_32x32x16_bf16(pa3,PK(3),o[d0],0,0,0);
    #undef PK
  }
}

#ifndef ATTN_STORE16
#define ATTN_STORE16(p,v) (*(u32x4*)(p)=(v))
#endif
struct AU { const bf16* Q; bf16* O; const bf16* K; const bf16* V; int kvp; int NT; int koff; int mode; int q0; float sink_l2; float* scr; float lam; const float* gsub; float sub_scale; };
template<int THRL,bool MASK> __device__ __forceinline__ void attn_unit(const AU&a,char*shm){
  int tid_=threadIdx.x; asm volatile("":"+v"(tid_)); const int tid=tid_,lane=tid&63,r32=lane&31,hi=lane>>5; const int wid=__builtin_amdgcn_readfirstlane(tid>>6);
  const bf16*Qw=a.Q+(long)(wid*QBLK)*QP;
  const bf16*Kh=a.K,*Vh=a.V; const long kvp=a.kvp; const int koff=a.koff;
  const unsigned lds0=(unsigned)(uintptr_t)shm;
  float*wsf=(float*)(shm+LDS_WS)+wid*64;
  const bf16*ksrc=Kh+(long)lane*kvp+wid*8;
  const bf16*vsrc=Vh+(long)(16*(wid&3)+(lane>>2))*kvp+(wid>>2)*32+(lane&3)*8;
  const unsigned kdst=lds0+LDS_K+wid*1024, vdst=lds0+LDS_V+wid*1024;
  #define TROW(t) (KVBLK*(t)+(((t)>=4)?koff:0))
  #define DMA_K(t,slot) glds16(ksrc+(long)TROW(t)*kvp,(unsigned)__builtin_amdgcn_readfirstlane(kdst+(slot)))
  #define DMA_V(t,slot) glds16(vsrc+(long)TROW(t)*kvp,(unsigned)__builtin_amdgcn_readfirstlane(vdst+(slot)))
  const int vb0=(int)(lds0+LDS_V)+((lane>>4)&1)*32+(lane&3)*8+(4*hi+((lane&15)>>2))*64;
  const char*Kbase=shm+LDS_K; bf16x8 kf[8];
  const lds_cptr shm3=(lds_cptr)shm; const lds_cptr kp0=shm3+LDS_K+hi*1024+r32*16; const lds_cptr vp0=shm3+LDS_V+((lane>>4)&1)*32+(lane&3)*8+(4*hi+((lane&15)>>2))*64;
  const int NT=a.NT;
  DMA_K(0,0);DMA_V(0,0);DMA_K(1,SLOTB);
  bf16x8 qr[4];
  #pragma unroll
  for(int d0=0;d0<4;++d0)qr[d0]=*reinterpret_cast<const bf16x8*>(&Qw[(long)r32*QP+d0*16+hi*8]);
  if(a.mode==2){qr[2]=bf16x8{};qr[3]=bf16x8{};} else if(a.mode==3){qr[0]=bf16x8{};qr[1]=bf16x8{};}
  float mhat=0.f,l_reg=0.f;f32x16 o[2];o[0]=f32x16{};o[1]=f32x16{};f32x16 negm=f32x16{};asm volatile("":"+v"(negm));
  const int qpos=a.q0+wid*QBLK+r32;
  #define CMASK(P0,P1,t) do{ if(MASK){ if((t)>=4) bmask(P0,P1,koff+KVBLK*((t)-4)-qpos,hi); } }while(0)
  bool resc=false;
  #define START(P0,P1) do{ const float rm=rowmax(P0,P1); resc=false; \
    { const float dl=rm; mhat=fadd_s(mhat,dl); \
      _Pragma("unroll") for(int r=0;r<16;++r){P0[r]=fsub_s(P0[r],dl);P1[r]=fsub_s(P1[r],dl);} \
      _Pragma("unroll") for(int r=0;r<16;++r)negm[r]=-mhat; asm volatile("":"+v"(negm)); } \
    _Pragma("unroll") for(int r=0;r<16;++r)P0[r]=__builtin_amdgcn_exp2f(P0[r]); }while(0)
  #define RESC() do{ if(resc){ asm volatile("s_waitcnt lgkmcnt(0)":::"memory"); \
      _Pragma("unroll") for(int d_=0;d_<2;++d_) _Pragma("unroll") for(int r=0;r<16;++r)o[d_][r]*=wsf[crow(r,hi)]; } }while(0)
  f32x16 pA0,pA1,pB0,pB1;
  int sl_prev=0,sl_cur=0,sl_next=SLOTB;
  #define ROT() do{sl_prev=sl_cur;sl_cur=sl_next;sl_next=(sl_next==(NSLOT-1)*SLOTB)?0:sl_next+SLOTB;}while(0)
  DMA_K(2,2*SLOTB);
  WAIT_BAR(3);
  qkt(pA0,pA1,Kbase,qr,negm,r32,hi);asm volatile("s_nop 15\n\ts_nop 7":"+v"(pA0),"+v"(pA1));CMASK(pA0,pA1,0);
  START(pA0,pA1);
  _Pragma("unroll") for(int r=0;r<16;++r)pA1[r]=__builtin_amdgcn_exp2f(pA1[r]);
  WAIT_BAR(0);
  DMA_K(3,0);DMA_V(1,SLOTB);
  ROT();
  kload8(kf,kp0+sl_cur);
  WAIT_BAR(2);
  s16x4 vlo[8],vhi[8]; u32x4 pw0,pw1,pw2,pw3;
  #define PKW(P,B) cvtpk_s(P[B],P[B+1])
  #define PAF(k) __builtin_bit_cast(bf16x8,pw##k)
  #define VFR(i) (bf16x8){vlo[i][0],vlo[i][1],vlo[i][2],vlo[i][3],vhi[i][0],vhi[i][1],vhi[i][2],vhi[i][3]}
  #define PIN(x) asm volatile("":"+v"(x))
  #define MX3(a,b,c) __builtin_fmaxf(__builtin_fmaxf((a),(b)),(c))
  #define GAPA(MF,A0,A1,A2,A3,W0,W1,PW) do{ MF; sacc+=A0; sacc+=A1; sacc+=A2; sacc+=A3; PIN(sacc); W0; W1; PIN(PW); SBAR(); }while(0)
  #define EX(v) __builtin_amdgcn_exp2f(v)
  #define GAPB(MF,X,B) do{ MF; X[B]=EX(X[B]); X[B+1]=EX(X[B+1]); X[B+2]=EX(X[B+2]); X[B+3]=EX(X[B+3]); PIN(X); SBAR(); }while(0)
  #define VRD(i) do{ vlo[i]=vtr(vp_+(((i)>>2)*4096+((i)&3)*1024)); vhi[i]=vtr(vp_+(((i)>>2)*4096+((i)&3)*1024+512)); }while(0)
  #define KRD(G,j) do{ if(G){ kload2(kf,kp0+sl_next,j); SBAR(); } }while(0)
  #define STEP(C0,C1,P0,P1,t,GK,GV,GL) do{ SBAR(); \
    const lds_cptr vp_=vp0+sl_prev; \
    VRD(0); SBAR(); float sacc=(P0[0]+P0[1]); \
    GAPA(C0=__builtin_amdgcn_mfma_f32_32x32x16_bf16(kf[0],qr[0],negm,0,0,0), P0[2],P0[3],P0[4],P0[5],     pw0[0]=PKW(P0,0), pw0[1]=PKW(P0,2), pw0); \
    VRD(4); SBAR(); GAPA(C1=__builtin_amdgcn_mfma_f32_32x32x16_bf16(kf[1],qr[0],negm,0,0,0), P0[6],P0[7],P0[8],P0[9],     pw0[2]=PKW(P0,4), pw0[3]=PKW(P0,6), pw0); \
    VRD(1); SBAR(); GAPA(C0=__builtin_amdgcn_mfma_f32_32x32x16_bf16(kf[2],qr[1],C0,0,0,0),   P0[10],P0[11],P0[12],P0[13], pw1[0]=PKW(P0,8), pw1[1]=PKW(P0,10), pw1); \
    VRD(5); SBAR(); GAPA(C1=__builtin_amdgcn_mfma_f32_32x32x16_bf16(kf[3],qr[1],C1,0,0,0),   P0[14],P0[15],P1[0],P1[1],   pw1[2]=PKW(P0,12),pw1[3]=PKW(P0,14), pw1); \
    VRD(2); SBAR(); GAPA(C0=__builtin_amdgcn_mfma_f32_32x32x16_bf16(kf[4],qr[2],C0,0,0,0),   P1[2],P1[3],P1[4],P1[5],     pw2[0]=PKW(P1,0), pw2[1]=PKW(P1,2), pw2); \
    VRD(6); SBAR(); GAPA(C1=__builtin_amdgcn_mfma_f32_32x32x16_bf16(kf[5],qr[2],C1,0,0,0),   P1[6],P1[7],P1[8],P1[9],     pw2[2]=PKW(P1,4), pw2[3]=PKW(P1,6), pw2); \
    VRD(3); SBAR(); GAPA(C0=__builtin_amdgcn_mfma_f32_32x32x16_bf16(kf[6],qr[3],C0,0,0,0),   P1[10],P1[11],P1[12],P1[13], pw3[0]=PKW(P1,8), pw3[1]=PKW(P1,10), pw3); \
    VRD(7); SBAR(); GAPA(C1=__builtin_amdgcn_mfma_f32_32x32x16_bf16(kf[7],qr[3],C1,0,0,0),   P1[14],P1[15],0.f,0.f,       pw3[2]=PKW(P1,12),pw3[3]=PKW(P1,14), pw3); \
    l_reg+=sacc; \
    if(GK){DMA_K((t)+3,sl_cur);} if(GV){DMA_V((t)+1,sl_next);} \
    CMASK(C0,C1,t); \
    { float a=MX3(C0[0],C0[1],C1[0]),b=MX3(C0[2],C0[3],C1[1]); a=MX3(a,C1[2],C1[3]); \
      _Pragma("unroll") for(int r=4;r<16;r+=4){a=MX3(a,C0[r],C0[r+1]);b=MX3(b,C0[r+2],C0[r+3]);a=MX3(a,C1[r],C1[r+1]);b=MX3(b,C1[r+2],C1[r+3]);} \
      float rm=__builtin_fmaxf(a,b); { auto rr=__builtin_amdgcn_permlane32_swap(__float_as_uint(rm),__float_as_uint(rm),false,false); rm=__builtin_fmaxf(__uint_as_float(rr[0]),__uint_as_float(rr[1])); } \
      resc=false; \
      if(__builtin_expect(__any(rm>(float)THRL),0)){ const float dl=__builtin_fmaxf(rm,0.f); mhat+=dl; \
        _Pragma("unroll") for(int r=0;r<16;++r){C0[r]-=dl;C1[r]-=dl;} \
        _Pragma("unroll") for(int r=0;r<16;++r)negm[r]=-mhat; asm volatile("":"+v"(negm)); \
        const float f=__builtin_amdgcn_exp2f(-dl); l_reg*=f; if(hi==0)wsf[r32]=f; resc=true; } } \
    SBAR(); \
    GAPB(o[0]=__builtin_amdgcn_mfma_f32_32x32x16_bf16(PAF(0),VFR(0),o[0],0,0,0), C0,0); \
    GAPB(o[1]=__builtin_amdgcn_mfma_f32_32x32x16_bf16(PAF(0),VFR(4),o[1],0,0,0), C0,4); \
    KRD(GL,0); GAPB(o[0]=__builtin_amdgcn_mfma_f32_32x32x16_bf16(PAF(1),VFR(1),o[0],0,0,0), C0,8); \
    KRD(GL,1); GAPB(o[1]=__builtin_amdgcn_mfma_f32_32x32x16_bf16(PAF(1),VFR(5),o[1],0,0,0), C0,12); \
    KRD(GL,2); GAPB(o[0]=__builtin_amdgcn_mfma_f32_32x32x16_bf16(PAF(2),VFR(2),o[0],0,0,0), C1,0); \
    KRD(GL,3); GAPB(o[1]=__builtin_amdgcn_mfma_f32_32x32x16_bf16(PAF(2),VFR(6),o[1],0,0,0), C1,4); \
    GAPB(o[0]=__builtin_amdgcn_mfma_f32_32x32x16_bf16(PAF(3),VFR(3),o[0],0,0,0), C1,8); \
    GAPB(o[1]=__builtin_amdgcn_mfma_f32_32x32x16_bf16(PAF(3),VFR(7),o[1],0,0,0), C1,12); \
    }while(0)
  int t=1;
  for(;t+5<NT;t+=2){
    STEP(pB0,pB1,pA0,pA1,t,true,true,true);     WAIT_BAR(2); RESC(); ROT();
    STEP(pA0,pA1,pB0,pB1,t+1,true,true,true);   WAIT_BAR(2); RESC(); ROT();
  }
  #define ENDW(tt) do{ if((tt)+3<NT){WAIT_BAR(2);} else if((tt)+2<NT){WAIT_BAR(1);} else {WAIT_BAR(0);} }while(0)
  for(;t+1<NT;t+=2){
    STEP(pB0,pB1,pA0,pA1,t,(t+3<NT),(t+1<NT),(t+1<NT));       ENDW(t);   RESC(); ROT();
    STEP(pA0,pA1,pB0,pB1,t+1,(t+4<NT),(t+2<NT),(t+2<NT));     ENDW(t+1); RESC(); ROT();
  }
  STEP(pB0,pB1,pA0,pA1,NT-1,false,false,false); RESC();
  { float sacc=pB0[0]+pB0[1]; _Pragma("unroll") for(int r=2;r<16;++r)sacc+=pB0[r]; _Pragma("unroll") for(int r=0;r<16;++r)sacc+=pB1[r]; l_reg+=sacc;
    pw0=(u32x4){PKW(pB0,0),PKW(pB0,2),PKW(pB0,4),PKW(pB0,6)};pw1=(u32x4){PKW(pB0,8),PKW(pB0,10),PKW(pB0,12),PKW(pB0,14)};pw2=(u32x4){PKW(pB1,0),PKW(pB1,2),PKW(pB1,4),PKW(pB1,6)};pw3=(u32x4){PKW(pB1,8),PKW(pB1,10),PKW(pB1,12),PKW(pB1,14)};
    SBAR(); pv(o,vb0+sl_cur,PAF(0),PAF(1),PAF(2),PAF(3)); }
  #undef PKW
  #undef PAF
  #undef VFR
  #undef PIN
  #undef MX3
  #undef GAPA
  #undef GAPB
  #undef EX
  #undef VRD
  #undef KRD
  #undef STEP
  #undef ENDW
  {auto rr=__builtin_amdgcn_permlane32_swap(__float_as_uint(l_reg),__float_as_uint(l_reg),false,false);l_reg=__uint_as_float(rr[0])+__uint_as_float(rr[1]);}
  if(a.mode==1)l_reg+=__builtin_amdgcn_exp2f(a.sink_l2-mhat);
  if(hi==0)wsf[32+r32]=l_reg;asm volatile("s_waitcnt lgkmcnt(0)":::"memory");
  float rli[16];
  #pragma unroll
  for(int r=0;r<16;++r)rli[r]=__builtin_amdgcn_rcpf(wsf[32+crow(r,hi)]);
  bf16*Ow=a.O+(long)(wid*QBLK)*QP;
  if(a.mode==2){
    float*sc=a.scr+(long)wid*2048+lane;
    #pragma unroll
    for(int r=0;r<16;++r){
      #pragma unroll
      for(int d0=0;d0<2;++d0)sc[(2*r+d0)*64]=o[d0][r]*rli[r];}
  } else if(a.mode==3){
    const float*sc=a.scr+(long)wid*2048+lane; float*stf=(float*)(shm+LDS_OST)+wid*2048; float*pst=stf+hi*256+r32;
    #pragma unroll
    for(int r=0;r<16;++r){
      #pragma unroll
      for(int d0=0;d0<2;++d0)pst[((r&3)+8*(r>>2))*64+d0*32]=sc[(2*r+d0)*64]-a.lam*(o[d0][r]*rli[r]);}
    asm volatile("s_waitcnt lgkmcnt(0)":::"memory");
    const int c4=lane&15; const f32x4 gs4=*(const f32x4*)(a.gsub+4*c4); const float*prd=stf+(lane>>4)*64+4*c4; bf16*pwr=Ow+(long)(lane>>4)*QP+4*c4;
    #pragma unroll
    for(int i=0;i<8;++i){f32x4 v=*(const f32x4*)(prd+i*256);
      float ss=(v[0]*v[0]+v[1]*v[1])+(v[2]*v[2]+v[3]*v[3]); ss+=__shfl_xor(ss,1); ss+=__shfl_xor(ss,2); ss+=__shfl_xor(ss,4); ss+=__shfl_xor(ss,8);
      const float rn=rsqrtf(ss*(1.0f/64.0f)+1e-6f)*a.sub_scale; v=v*rn*gs4;
      u32x2 pk; pk.x=cvtpk_s(v[0],v[1]); pk.y=cvtpk_s(v[2],v[3]); *(u32x2*)(pwr+(long)i*4*QP)=pk;}
  } else
  { bf16*stg=(bf16*)(shm+LDS_OST)+wid*2048;
    #pragma unroll
    for(int r=0;r<16;++r){const int orow=crow(r,hi);
      #pragma unroll
      for(int d0=0;d0<2;++d0)stg[orow*64+d0*32+r32]=__float2bfloat16(o[d0][r]*rli[r]);}
    asm volatile("s_waitcnt lgkmcnt(0)":::"memory");
    #pragma unroll
    for(int i=0;i<4;++i){const int row=i*8+(lane>>3),ch=lane&7; const u32x4 v=*(const u32x4*)(stg+row*64+ch*8); ATTN_STORE16(Ow+(long)row*QP+ch*8,v);} }
  asm volatile("s_waitcnt lgkmcnt(0)\n\ts_barrier":::"memory");
  #undef DMA_K
  #undef DMA_V
  #undef CMASK
  #undef START
  #undef RESC
  #undef TROW
  #undef ROT
}
constexpr int ATTN_LDS_BYTES=LDS_BYTES;
#undef SBAR
#undef WAIT_BAR
}

constexpr int NWAVES = 8;
#ifndef MK_N_LAUNCHES
#define MK_N_LAUNCHES 1
#endif
constexpr int DEPTH = 2, DMODEL = 1024, DIN = 2048, DUP = 5632, DFF = 2816, NTOK = 12288, NPROMPT = 4096;
constexpr int N_PHASES = 2 + 6 * DEPTH + 1;
constexpr size_t MiB = 1u << 20;
constexpr size_t WS_CTL = 0, CTL_ZERO_BYTES = 1 * MiB;
constexpr int CW_TMO = 0, CW_CODE = 1, CW_BAR = 4096, CW_QUEUE = 8192;
constexpr size_t CTL_SUMSQ = 64 * 1024;
constexpr size_t CTL_MOD = 256 * 1024;
constexpr size_t CTL_CIN = 400 * 1024;
constexpr size_t CTL_CUP = 448 * 1024;
static_assert(CTL_CUP + (size_t)DEPTH * 3 * DUP * 4 <= CTL_ZERO_BYTES && CTL_SUMSQ + 4 * (size_t)NTOK * 4 <= CTL_MOD && CTL_MOD + (size_t)DEPTH * 3 * 6144 * 4 <= CTL_CIN && CTL_CIN + (size_t)DEPTH * 3 * DIN * 4 <= CTL_CUP, "ctl map");
constexpr size_t WS_SS0 = 1 * MiB;
constexpr size_t WS_ROPE = WS_SS0 + 64 * 1024;
constexpr size_t WS_LAM = WS_ROPE + 16 * 1024;
constexpr size_t WS_W = 2 * MiB;
constexpr size_t W_IN_OFF = 0, W_OUT_OFF = 4 * MiB, W_UP_OFF = 6 * MiB, W_DOWN_OFF = 17 * MiB, W_LAYER = 22 * MiB + MiB / 2;
constexpr size_t WS_R1 = 48 * MiB;
constexpr size_t R1_H1 = 0, R1_QO = 24 * MiB, R1_KV = 48 * MiB;
constexpr size_t WS_R2 = 180 * MiB;
constexpr size_t R2_H2 = 0, R2_SCR = 24 * MiB;
constexpr size_t WS_END = 246 * MiB;
static_assert(WS_W + DEPTH * W_LAYER <= WS_R1 && R1_KV + (size_t)pg8::KV_ELEMS * 2 <= 132 * MiB && R2_SCR + (size_t)4 * NTOK * 64 * 4 <= 66 * MiB && (size_t)NTOK * DUP * 2 <= 132 * MiB && (size_t)NTOK * DFF * 2 <= 66 * MiB, "ws map");
constexpr int RING_OFF = 0, RING_BYTES = 131072;
constexpr int LDSCTL_OFF = RING_BYTES, MISC_OFF = LDSCTL_OFF + 320;
constexpr int LDS_BYTES = 147456;
static_assert(attn_body::ATTN_LDS_BYTES <= RING_BYTES, "attention scratch fits the ring region");

#define GAS __attribute__((address_space(1)))
#define LAS __attribute__((address_space(3)))
typedef unsigned short bf16;
typedef unsigned v4u __attribute__((ext_vector_type(4)));
typedef float f32x4 __attribute__((ext_vector_type(4)));
typedef short bf16x8 __attribute__((ext_vector_type(8)));
typedef GAS unsigned gu32;
typedef GAS unsigned long long gu64;
#define RLX_AGENT __ATOMIC_RELAXED, __HIP_MEMORY_SCOPE_AGENT
#define LDS_WAIT() asm volatile("s_waitcnt lgkmcnt(0)" ::: "memory")
#define VM_WAIT() asm volatile("s_waitcnt vmcnt(0)" ::: "memory")
__device__ __forceinline__ unsigned long long rt() { return __builtin_amdgcn_s_memrealtime(); }
__device__ __forceinline__ unsigned f2bf(float f) { unsigned u = __builtin_bit_cast(unsigned, f); return (u + 0x7fffu + ((u >> 16) & 1u)) >> 16; }
__device__ __forceinline__ unsigned pk2(float lo, float hi) { return f2bf(lo) | (f2bf(hi) << 16); }

#define XB_TMO      128
#define XB_XCNT(j)  (256  + 64 * (j))
#define XB_XSUB(j)  (1280 + 64 * (j))
#define XB_XGEN(j)  (2304 + 64 * (j))
#define XB_TOP      3328
#define XB_TOPGEN   3392
#define XCD_BAR_WORDS 3456
#define XB_SPIN_CAP (1u << 18)

__device__ __forceinline__ unsigned xb_ld(unsigned* p)              { return __hip_atomic_load(p, __ATOMIC_RELAXED, __HIP_MEMORY_SCOPE_AGENT); }
__device__ __forceinline__ unsigned xb_add(unsigned* p, unsigned v) { return __hip_atomic_fetch_add(p, v, __ATOMIC_RELAXED, __HIP_MEMORY_SCOPE_AGENT); }
__device__ __forceinline__ unsigned xb_xcc_id() { return (unsigned)__builtin_amdgcn_s_getreg((3 << 11) | 20) & 0xFu; }
#define XB_SPIN(cond, bar) do { unsigned _sp = 0; while (cond) { __builtin_amdgcn_s_sleep(1); \
    if ((++_sp & 255u) == 0u) { if (xb_ld(&(bar)[XB_TMO])) break; if (_sp > XB_SPIN_CAP) { atomicAdd(&(bar)[XB_TMO], 1u); break; } } } } while (0)

struct XcdBarrier {
    unsigned* bar; unsigned x;
    volatile LAS unsigned* st;
};

__device__ __forceinline__ XcdBarrier xcd_barrier_post(unsigned* bar, volatile LAS unsigned* st) {
    XcdBarrier b; b.bar = bar; b.x = xb_xcc_id(); b.st = st;
    if (threadIdx.x == 0) (void)xb_add(&bar[XB_XCNT(b.x)], 1u);
    return b;
}
__device__ __forceinline__ void xcd_barrier_complete(unsigned* bar, unsigned x, unsigned& nloc, unsigned& nx) {
    const unsigned G = gridDim.x * gridDim.y * gridDim.z;
    unsigned sum, cnt, mine, sp = 0u;
    for (;;) {
        sum = 0u; cnt = 0u; mine = 0u;
#pragma unroll
        for (unsigned j = 0; j < 16; ++j) { const unsigned c = xb_ld(&bar[XB_XCNT(j)]); sum += c; cnt += (c > 0u) ? 1u : 0u; mine = (j == x) ? c : mine; }
        if (sum == G) break;
        __builtin_amdgcn_s_sleep(1);
        if ((++sp & 255u) == 0u) { if (xb_ld(&bar[XB_TMO])) break; if (sp > XB_SPIN_CAP) { atomicAdd(&bar[XB_TMO], 1u); break; } }
    }
    nloc = mine > 0u ? mine : 1u; nx = cnt > 0u ? cnt : 1u;
}

__device__ __forceinline__ void xcd_barrier(const XcdBarrier& b) {
    asm volatile("s_waitcnt vmcnt(0)" ::: "memory");
    __syncthreads();
    if (threadIdx.x == 0) {
        unsigned* bar = b.bar;
        __builtin_amdgcn_s_waitcnt(0);
        unsigned nloc = b.st[0], nx = b.st[1];
        if (nloc == 0u) { xcd_barrier_complete(bar, b.x, nloc, nx); b.st[0] = nloc; b.st[1] = nx; }
        const unsigned old = xb_add(&bar[XB_XSUB(b.x)], 1u);
        const unsigned gen = old / nloc;
        if (old + 1u == (gen + 1u) * nloc) {
            __builtin_amdgcn_fence(__ATOMIC_RELEASE, "agent");
            asm volatile("s_waitcnt vmcnt(0)" ::: "memory");
            const unsigned og = xb_add(&bar[XB_TOP], 1u);
            const unsigned tg = og / nx;
            if (og + 1u == (tg + 1u) * nx) xb_add(&bar[XB_TOPGEN], 1u);
            else XB_SPIN(xb_ld(&bar[XB_TOPGEN]) == tg, bar);
            __builtin_amdgcn_fence(__ATOMIC_ACQUIRE, "agent");
            xb_add(&bar[XB_XGEN(b.x)], 1u);
            asm volatile("s_waitcnt vmcnt(0)" ::: "memory");
        } else {
            XB_SPIN(xb_ld(&bar[XB_XGEN(b.x)]) == gen, bar);
            __builtin_amdgcn_fence(__ATOMIC_ACQUIRE, "agent");
            asm volatile("s_waitcnt vmcnt(0)" ::: "memory");
        }
    }
    __syncthreads();
}


struct Frame {
    LAS unsigned char* lds; volatile LAS unsigned* MISC; gu32* ctl;
    int tid, lane, wave, vcu, G;
    const float* const* in; float* out; unsigned char* ws;
};
__device__ __forceinline__ float wave_sum(float v) {
#pragma unroll
    for (int o = 1; o < 64; o <<= 1) v += __shfl_xor(v, o);
    return v;
}
template <class T> __device__ __forceinline__ T* uni(T* p) {
    const unsigned long long v = (unsigned long long)p; const unsigned lo = __builtin_amdgcn_readfirstlane((unsigned)v), hi = __builtin_amdgcn_readfirstlane((unsigned)(v >> 32));
    return (T*)(GAS T*)(((unsigned long long)hi << 32) | lo);
}
__device__ __forceinline__ float silu_f(float x) { return x / (1.0f + __expf(-x)); }

__device__ __forceinline__ int phys_in(int L) {
    const int g = L >> 6, d = L & 63, pn = g >> 2, wc = g & 3, bj = d >> 5; int n, fq, j;
    if (g >= 20 && g < 28) { const int x = d & 31, p = x >> 4, i = x & 7; n = (x >> 3) & 1; fq = 2 * p + (i >> 2); j = i & 3; }
    else { n = (d >> 4) & 1; fq = (d >> 2) & 3; j = d & 3; }
    return 256 * pn + 128 * bj + 32 * wc + 16 * n + 4 * fq + j;
}
__device__ __forceinline__ int phys_up(int L) {
    const int pn = L >> 8, c = L & 255, bj = c >> 7, wc = (c >> 5) & 3, y = c & 31, fq = y >> 3, n = (y >> 2) & 1, j = y & 3;
    return 256 * pn + 128 * bj + 32 * wc + 16 * n + 4 * fq + j;
}
template <int PM> __device__ __forceinline__ void transpose_item(const float* W, int K, int N, bf16* WT, LAS float* scr, int item, int lane, const float* shp, float* cdst) {
    const int nblk = N / 32, kb = item / nblk, nb = item % nblk, k0 = 64 * kb, n0 = 32 * nb;
#pragma unroll 8
    for (int i = 0; i < 32; ++i) { const int kk = 2 * i + (lane >> 5); scr[kk * 33 + (lane & 31)] = W[(size_t)(k0 + kk) * N + n0 + (lane & 31)]; }
    LDS_WAIT(); asm volatile("" ::: "memory");
    const int c = lane & 7;
#pragma unroll
    for (int j = 0; j < 4; ++j) { const int n = (lane >> 3) + 8 * j; const LAS float* s = scr + (8 * c) * 33 + n;
        v4u o; o.x = pk2(s[0 * 33], s[1 * 33]); o.y = pk2(s[2 * 33], s[3 * 33]); o.z = pk2(s[4 * 33], s[5 * 33]); o.w = pk2(s[6 * 33], s[7 * 33]);
        const int L = n0 + n, row = (PM == 1) ? phys_in(L) : (PM == 2) ? phys_up(L) : L;
        *(GAS v4u*)(WT + (size_t)row * K + k0 + 8 * c) = o; }
    if (shp) {
        const int n = lane & 31, kh = lane >> 5; float a0 = 0.f, a1 = 0.f, a2 = 0.f;
#pragma unroll 8
        for (int kk = 0; kk < 32; ++kk) { const float w = scr[(32 * kh + kk) * 33 + n]; const int k = k0 + 32 * kh + kk; a0 += shp[k] * w; a1 += shp[6144 + k] * w; a2 += shp[2 * 6144 + k] * w; }
        a0 += __shfl_xor(a0, 32); a1 += __shfl_xor(a1, 32); a2 += __shfl_xor(a2, 32);
        if (lane < 32) { unsafeAtomicAdd(cdst + n0 + n, a0); unsafeAtomicAdd(cdst + N + n0 + n, a1); unsafeAtomicAdd(cdst + 2 * N + n0 + n, a2); }
    }
    LDS_WAIT(); asm volatile("" ::: "memory");
}

__device__ __forceinline__ void relane(Frame& F) { int t = threadIdx.x; asm volatile("" : "+v"(t)); F.tid = t; F.lane = t & 63; F.wave = __builtin_amdgcn_readfirstlane(t >> 6); }
__device__ __forceinline__ void p0a(Frame& F) {
    relane(F);
    LAS float* sil = (LAS float*)(F.lds + RING_OFF);
    for (int i = F.tid; i < 3 * DMODEL; i += NWAVES * 64) { const int c = i >> 10, k = i & 1023; const float x = (c == 0) ? F.in[9][k] : F.in[8][(c - 1) * DMODEL + k]; sil[i] = silu_f(x); }
    __syncthreads();
    const int gw = F.vcu * NWAVES + F.wave, NGW = F.G * NWAVES;
    float* mod = (float*)(F.ws + WS_CTL + CTL_MOD);
    for (int it = gw; it < DEPTH * 24 * 32; it += NGW) {
        const int l = it / 768, r = it % 768, cb = r >> 5, kc = r & 31, col = cb * 256 + F.lane * 4;
        const float* wp = F.in[10] + ((size_t)l * DMODEL + kc * 32) * 6144 + col;
        f32x4 a0 = {0.f, 0.f, 0.f, 0.f}, a1 = a0, a2 = a0;
#pragma unroll 8
        for (int kk = 0; kk < 32; ++kk) { const f32x4 w = *(const f32x4*)(wp + (size_t)kk * 6144); const int k = kc * 32 + kk; a0 += w * sil[k]; a1 += w * sil[1024 + k]; a2 += w * sil[2048 + k]; }
        if (kc == 0) { const f32x4 b = *(const f32x4*)(F.in[11] + l * 6144 + col); a0 += b; a1 += b; a2 += b; }
        float* mp = mod + (size_t)l * 3 * 6144 + col;
#pragma unroll
        for (int j = 0; j < 4; ++j) { unsafeAtomicAdd(mp + j, a0[j]); unsafeAtomicAdd(mp + 6144 + j, a1[j]); unsafeAtomicAdd(mp + 2 * 6144 + j, a2[j]); }
    }
    __syncthreads();
    LAS float* scr = (LAS float*)(F.lds + RING_OFF + F.wave * 16384);
    constexpr int I_O = (DMODEL / 64) * (DMODEL / 32), I_D = (DFF / 64) * (DMODEL / 32);
    for (int it = gw; it < DEPTH * (I_O + I_D); it += NGW) {
        const int l = it / (I_O + I_D); int r = it % (I_O + I_D);
        bf16* wl = (bf16*)(F.ws + WS_W + l * W_LAYER);
        if (r < I_O) transpose_item<0>(F.in[23] + (size_t)l * DMODEL * DMODEL, DMODEL, DMODEL, (bf16*)((unsigned char*)wl + W_OUT_OFF), scr, r, F.lane, nullptr, nullptr);
        else transpose_item<0>(F.in[27] + (size_t)l * DFF * DMODEL, DFF, DMODEL, (bf16*)((unsigned char*)wl + W_DOWN_OFF), scr, r - I_O, F.lane, nullptr, nullptr);
    }
    const int gt = F.vcu * NWAVES * 64 + F.tid;
    float* rope = (float*)(F.ws + WS_ROPE);
    if (gt < 1024) { const int pos = gt >> 4, i = gt & 15; const double ang = (double)pos * pow(10000.0, -(double)i / 16.0); rope[gt] = (float)cos(ang); rope[1024 + gt] = (float)sin(ang); }
    else if (gt < 1536) { const int q = gt - 1024, pos = q >> 3, i = q & 7; const double ang = (double)pos * pow(10000.0, -(double)i / 8.0); rope[2048 + q] = (float)cos(ang); rope[2560 + q] = (float)sin(ang); }
    else if (gt < 1536 + DEPTH) { const int l = gt - 1536; float s1 = 0.f, s2 = 0.f;
        for (int i = 0; i < 32; ++i) { s1 += F.in[18][l * 32 + i] * F.in[19][l * 32 + i]; s2 += F.in[20][l * 32 + i] * F.in[21][l * 32 + i]; }
        const float lam_init = 0.8f - 0.6f * expf(-0.3f * (float)l);
        ((float*)(F.ws + WS_LAM))[l] = expf(s1) - expf(s2) + lam_init; }
}
__device__ __forceinline__ void p0b(Frame& F) {
    relane(F);
    LAS float* scr = (LAS float*)(F.lds + RING_OFF + F.wave * 16384);
    const int gw = F.vcu * NWAVES + F.wave, NGW = F.G * NWAVES;
    const float* mod = (const float*)(F.ws + WS_CTL + CTL_MOD);
    constexpr int I_I = (DMODEL / 64) * (DIN / 32), I_U = (DMODEL / 64) * (DUP / 32);
    for (int it = gw; it < DEPTH * (I_I + I_U); it += NGW) {
        const int l = it / (I_I + I_U); int r = it % (I_I + I_U);
        unsigned char* wl = F.ws + WS_W + l * W_LAYER; const float* ml = mod + (size_t)l * 3 * 6144;
        if (r < I_I) transpose_item<1>(F.in[14] + (size_t)l * DMODEL * DIN, DMODEL, DIN, (bf16*)(wl + W_IN_OFF), scr, r, F.lane, ml + 0, (float*)(F.ws + WS_CTL + CTL_CIN) + (size_t)l * 3 * DIN);
        else transpose_item<2>(F.in[24] + (size_t)l * DMODEL * DUP, DMODEL, DUP, (bf16*)(wl + W_UP_OFF), scr, r - I_I, F.lane, ml + 3072, (float*)(F.ws + WS_CTL + CTL_CUP) + (size_t)l * 3 * DUP);
    }
    bf16* H1 = (bf16*)(F.ws + WS_R1 + R1_H1); float* ss0 = (float*)(F.ws + WS_SS0);
    for (int m = gw; m < NTOK; m += NGW) {
        const float* xr = (m < NPROMPT) ? F.in[0] + (size_t)m * DMODEL : F.in[1] + (size_t)(m - NPROMPT) * DMODEL;
        const int cond = (m < NPROMPT) ? 0 : 1 + ((m - NPROMPT) >> 12);
        const float* sc = mod + (size_t)cond * 6144 + 1024; const float* g1 = F.in[12];
        float s = 0.f; GAS unsigned long long* o8 = (GAS unsigned long long*)(H1 + (size_t)m * DMODEL) + F.lane;
#pragma unroll
        for (int j = 0; j < 4; ++j) { const int k = 4 * F.lane + 256 * j; const f32x4 v = *(const f32x4*)(xr + k); s += (v.x * v.x + v.y * v.y) + (v.z * v.z + v.w * v.w);
            const f32x4 w = v * (*(const f32x4*)(g1 + k)) * (*(const f32x4*)(sc + k) + 1.0f);
            o8[64 * j] = (unsigned long long)pk2(w.x, w.y) | ((unsigned long long)pk2(w.z, w.w) << 32); }
        s = wave_sum(s); if (F.lane == 0) ss0[m] = s;
    }
}
__device__ __forceinline__ void cache_rows(Frame& F, int l) {
    relane(F);
    bf16* KV = (bf16*)(F.ws + WS_R1 + R1_KV);
    const int gt = F.vcu * NWAVES * 64 + F.tid, NT_ = F.G * NWAVES * 64;
    for (int i = gt; i < 131072; i += NT_) {
        int which, q; if (i < 65536) { which = i >> 14; q = i & 16383; } else { which = 4 + ((i - 65536) >> 15); q = (i - 65536) & 32767; }
        const int pitch = which < 4 ? 128 : 256, per = 256 * pitch / 4;
        const int s = q / per, e = (q % per) * 4, p = e / pitch, c = e % pitch;
        const f32x4 v = *(const f32x4*)(F.in[2 + which] + ((size_t)(s * DEPTH + l) * 256 + p) * pitch + c);
        const long off = which == 0 ? pg8::KA_S : which == 1 ? pg8::VA_S : which == 2 ? pg8::KB_S : which == 3 ? pg8::VB_S : which == 4 ? pg8::KC_S : pg8::VC_S;
        *(GAS unsigned long long*)(KV + off + ((size_t)s * 4352 + p) * pitch + c) = (unsigned long long)pk2(v.x, v.y) | ((unsigned long long)pk2(v.z, v.w) << 32);
    }
}
constexpr int N_ATTN_UNITS = 768;
__device__ __forceinline__ void attn_phase(Frame& F, int l) {
    relane(F);
    bf16* QO = (bf16*)(F.ws + WS_R1 + R1_QO); const bf16* KV = (const bf16*)(F.ws + WS_R1 + R1_KV);
    float* scrb = (float*)(F.ws + WS_R2 + R2_SCR);
    const float lam = ((const float*)(F.ws + WS_LAM))[l]; const float lam_init = 0.8f - 0.6f * expf(-0.3f * (float)l);
    const float* sink = F.in[17] + l * 6; const float* gsub = F.in[22] + l * 64;
    gu32* qc = F.ctl + CW_QUEUE + 64 * l;
    char* shm = (char*)F.lds + RING_OFF;
    for (;;) {
        if (F.tid == 0) F.MISC[16] = __hip_atomic_fetch_add(qc, 1u, RLX_AGENT);
        __syncthreads();
        const int idx = __builtin_amdgcn_readfirstlane((int)F.MISC[16]);
        if (idx >= N_ATTN_UNITS) break;
        attn_body::AU a; a.scr = nullptr; a.lam = lam; a.gsub = gsub; a.sub_scale = 1.0f - lam_init; a.sink_l2 = 0.f; a.koff = 0; a.q0 = 0;
        int mix, smp, s, h, qb;
        if (idx < 128) { mix = 2; smp = 1; s = idx >> 6; h = (idx >> 4) & 3; qb = idx & 15; }
        else if (idx < 320) { const int j = idx - 128; mix = 0; smp = 1; s = j / 96; h = (j % 96) >> 4; qb = j & 15; }
        else if (idx < 512) { const int j = idx - 320; mix = 1; smp = 1; s = j / 96; h = (j % 96) >> 4; qb = j & 15; }
        else if (idx < 576) { const int j = idx - 512; mix = 2; smp = 0; s = j >> 2; h = j & 3; qb = 0; }
        else if (idx < 672) { const int j = idx - 576; mix = 0; smp = 0; s = j / 6; h = j % 6; qb = 0; }
        else { const int j = idx - 672; mix = 1; smp = 0; s = j / 6; h = j % 6; qb = 0; }
        const long row0 = smp ? NPROMPT + (long)s * 4096 + qb * 256 : (long)s * 256;
        const int kvh = (mix == 2) ? h : h / 3; const int pitch = (mix == 2) ? 256 : 128;
        const long koffs = smp ? (mix == 0 ? pg8::KA_S : mix == 1 ? pg8::KB_S : pg8::KC_S) : (mix == 0 ? pg8::KA_P : mix == 1 ? pg8::KB_P : pg8::KC_P);
        const long voffs = smp ? (mix == 0 ? pg8::VA_S : mix == 1 ? pg8::VB_S : pg8::VC_S) : (mix == 0 ? pg8::VA_P : mix == 1 ? pg8::VB_P : pg8::VC_P);
        const long seqrow = smp ? (long)s * 4352 : (long)s * 256;
        a.Q = (const attn_body::bf16*)(QO + row0 * 1024 + (mix == 0 ? 0 : mix == 1 ? 384 : 768) + h * 64); a.O = (attn_body::bf16*)a.Q;
        a.K = (const attn_body::bf16*)(KV + koffs + seqrow * pitch + kvh * 64); a.V = (const attn_body::bf16*)(KV + voffs + seqrow * pitch + kvh * 64); a.kvp = pitch;
        a.NT = smp ? 68 : 4; a.q0 = qb * 256;
        int npass = 1;
        if (mix == 2) { a.scr = scrb + ((size_t)h * NTOK + row0) * 64; a.mode = 2; npass = 2; }
        else { a.mode = (mix == 1) ? 1 : 0; if (mix == 1) a.sink_l2 = sink[h] * pg8::LOG2E; }
        if (mix == 1 && smp) {
            const int q0 = qb * 256, ks = (q0 - 128 > 0) ? q0 - 128 : 0, ke = (q0 + 384 < 4096) ? q0 + 384 : 4096;
            a.koff = ks; a.NT = 4 + (ke - ks) / 64;
            attn_body::attn_unit<8, true>(a, shm);
        } else {
#pragma unroll 1
            for (int ps = 0; ps < npass; ++ps) { attn_body::attn_unit<8, false>(a, shm); a.mode = 3; }
        }
    }
}
__device__ __forceinline__ void conv_phase(Frame& F, int l) {
    relane(F);
    const bf16* U = (const bf16*)(F.ws + WS_R1); bf16* ACT = (bf16*)(F.ws + WS_R2);
    const float* cw = F.in[25] + (size_t)l * 3 * DUP; const float* cb = F.in[26] + (size_t)l * DUP;
    if (F.tid >= 352) return;
    const int c0 = F.tid * 8;
    float w[2][3][8], b[2][8];
#pragma unroll
    for (int hf = 0; hf < 2; ++hf) {
#pragma unroll
        for (int k = 0; k < 3; ++k) { const f32x4 x0 = *(const f32x4*)(cw + k * DUP + hf * DFF + c0), x1 = *(const f32x4*)(cw + k * DUP + hf * DFF + c0 + 4);
#pragma unroll
            for (int j = 0; j < 4; ++j) { w[hf][k][j] = x0[j]; w[hf][k][4 + j] = x1[j]; } }
        const f32x4 y0 = *(const f32x4*)(cb + hf * DFF + c0), y1 = *(const f32x4*)(cb + hf * DFF + c0 + 4);
#pragma unroll
        for (int j = 0; j < 4; ++j) { b[hf][j] = y0[j]; b[hf][4 + j] = y1[j]; }
    }
    for (int strip = F.vcu; strip < NTOK / 48; strip += F.G) {
        const int r0 = strip * 48;
        v4u pa, pg, ca, cg, na, ng;
        if (r0 > 0) { pa = *(const GAS v4u*)(U + (size_t)(r0 - 1) * DUP + c0); pg = *(const GAS v4u*)(U + (size_t)(r0 - 1) * DUP + DFF + c0); } else { pa = (v4u){0u, 0u, 0u, 0u}; pg = pa; }
        ca = *(const GAS v4u*)(U + (size_t)r0 * DUP + c0); cg = *(const GAS v4u*)(U + (size_t)r0 * DUP + DFF + c0);
        for (int r = r0; r < r0 + 48; ++r) {
            const int t = (r < NPROMPT) ? (r & 255) : ((r - NPROMPT) & 4095), T = (r < NPROMPT) ? 256 : 4096;
            const float fp = (t > 0) ? 1.0f : 0.0f, fn = (t < T - 1) ? 1.0f : 0.0f;
            if (r + 1 < NTOK) { na = *(const GAS v4u*)(U + (size_t)(r + 1) * DUP + c0); ng = *(const GAS v4u*)(U + (size_t)(r + 1) * DUP + DFF + c0); } else { na = (v4u){0u, 0u, 0u, 0u}; ng = na; }
            v4u o;
#pragma unroll
            for (int q = 0; q < 4; ++q) {
                float res[2];
#pragma unroll
                for (int e = 0; e < 2; ++e) { const int j = 2 * q + e;
                    const float ap = e ? __uint_as_float(pa[q] & 0xffff0000u) : __uint_as_float(pa[q] << 16), ac = e ? __uint_as_float(ca[q] & 0xffff0000u) : __uint_as_float(ca[q] << 16), an = e ? __uint_as_float(na[q] & 0xffff0000u) : __uint_as_float(na[q] << 16);
                    const float gp = e ? __uint_as_float(pg[q] & 0xffff0000u) : __uint_as_float(pg[q] << 16), gc = e ? __uint_as_float(cg[q] & 0xffff0000u) : __uint_as_float(cg[q] << 16), gn = e ? __uint_as_float(ng[q] & 0xffff0000u) : __uint_as_float(ng[q] << 16);
                    const float av = w[0][0][j] * (fp * ap) + w[0][1][j] * ac + w[0][2][j] * (fn * an) + b[0][j];
                    const float gv = w[1][0][j] * (fp * gp) + w[1][1][j] * gc + w[1][2][j] * (fn * gn) + b[1][j];
                    res[e] = silu_f(av) * gv; }
                o[q] = pk2(res[0], res[1]);
            }
            *(GAS v4u*)(ACT + (size_t)r * DFF + c0) = o;
            pa = ca; pg = cg; ca = na; cg = ng;
        }
    }
}
__device__ __forceinline__ void final_phase(Frame& F) {
    relane(F);
    const float* ssq = (const float*)(F.ws + WS_CTL + CTL_SUMSQ) + 3 * (size_t)NTOK; const float* gf = F.in[28];
    const int gt = F.vcu * NWAVES * 64 + F.tid, NT_ = F.G * NWAVES * 64;
    for (int i = gt; i < NTOK * 256; i += NT_) { const int row = i >> 8, c = (i & 255) * 4;
        const float rstd = rsqrtf(ssq[row] * (1.0f / 1024.0f) + 1e-6f);
        f32x4* p = (f32x4*)(F.out + (size_t)row * DMODEL + c); *p = *p * rstd * (*(const f32x4*)(gf + c)); }
}

struct Args { const float* in[29]; float* out; unsigned char* ws; int ph_lo, ph_hi; };
__global__ void __launch_bounds__(NWAVES * 64, 2) fwd_kernel(const Args args) {
    extern __shared__ __attribute__((aligned(16))) unsigned char lds[];
    Frame F;
    F.lds = (LAS unsigned char*)lds; F.MISC = (volatile LAS unsigned*)(F.lds + MISC_OFF);
    F.tid = threadIdx.x; F.lane = F.tid & 63; F.wave = __builtin_amdgcn_readfirstlane(F.tid >> 6);
    F.G = gridDim.x; { const int bx = blockIdx.x; F.vcu = (F.G % 8 == 0) ? (bx % 8) * (F.G / 8) + bx / 8 : bx; }
    F.in = args.in;
    F.out = args.out; F.ws = args.ws; F.ctl = (gu32*)(args.ws + WS_CTL);
    for (int u = F.tid; u < (LDS_BYTES - LDSCTL_OFF) / 4; u += NWAVES * 64) ((LAS unsigned*)(F.lds + LDSCTL_OFF))[u] = 0u;
    __syncthreads();
    const int lo = args.ph_lo, hi = args.ph_hi;
    XcdBarrier bar; bar.bar = (unsigned*)(F.ctl + CW_BAR); bar.x = 0; bar.st = nullptr;
    if (hi - lo > 1) bar = xcd_barrier_post((unsigned*)(F.ctl + CW_BAR), F.MISC + 8);
#ifndef PH_MASK
#define PH_MASK 0xffffffffu
#endif
#define IN(k) (lo <= (k) && (k) < hi && ((PH_MASK >> (((k) < 2) ? (k) : (k) == N_PHASES - 1 ? 8 : 2 + ((k) - 2) % 6)) & 1u))
#define SEAM(k) do { if (IN(k) && IN((k) + 1)) xcd_barrier(bar); } while (0)
    unsigned char* ws = uni(args.ws); F.ws = ws; F.out = uni(args.out); F.ctl = (gu32*)(ws + WS_CTL);
    float* mod = (float*)(ws + WS_CTL + CTL_MOD); float* ssq = (float*)(ws + WS_CTL + CTL_SUMSQ);
    if (IN(0)) { p0a(F); } SEAM(0);
    if (IN(1)) { p0b(F); } SEAM(1);
#pragma unroll 1
    for (int l = 0; l < DEPTH; ++l) {
        const int pb = 2 + 6 * l;
        unsigned char* wl = ws + WS_W + l * W_LAYER;
        const float* ml = mod + (size_t)l * 3 * 6144;
        if (IN(pb)) {
            cache_rows(F, l);
            pg8::Gemm g{(const pg8::bf16_t*)(ws + WS_R1 + R1_H1), (const pg8::bf16_t*)(wl + W_IN_OFF), NTOK, DIN, DMODEL}; pg8::StaticOrder S; S.init(NTOK, DIN, F.G, (int)blockIdx.x);
            pg8::EpiIn E{l, l == 0 ? (const float*)(ws + WS_SS0) : ssq + (size_t)NTOK, (const float*)(ws + WS_CTL + CTL_CIN) + (size_t)l * 3 * DIN, F.in[15] + l * 64, F.in[16] + l * 64,
                         (const float*)(ws + WS_ROPE), (pg8::bf16_t*)(ws + WS_R1 + R1_QO), (pg8::bf16_t*)(ws + WS_R1 + R1_KV), F.out};
            pg8::gemm_phase<pg8::EpiIn, pg8::StaticOrder, true, true>(F.lds + RING_OFF, g, S, E);
        } SEAM(pb);
        if (IN(pb + 1)) { attn_phase(F, l); } SEAM(pb + 1);
        if (IN(pb + 2)) {
            pg8::Gemm g{(const pg8::bf16_t*)(ws + WS_R1 + R1_QO), (const pg8::bf16_t*)(wl + W_OUT_OFF), NTOK, DMODEL, DMODEL}; pg8::StaticOrder S; S.init(NTOK, DMODEL, F.G, (int)blockIdx.x);
            pg8::EpiRes E{l == 0 ? F.in[0] : F.out, l == 0 ? F.in[1] : F.out + (size_t)NPROMPT * DMODEL, F.out, ml + 2048, F.in[13] + l * DMODEL, ml + 4096,
                          (pg8::bf16_t*)(ws + WS_R2 + R2_H2), ssq + (size_t)(l == 0 ? 0 : 2) * NTOK};
            pg8::gemm_phase<pg8::EpiRes, pg8::StaticOrder, true, true>(F.lds + RING_OFF, g, S, E);
        } SEAM(pb + 2);
        if (IN(pb + 3)) {
            pg8::Gemm g{(const pg8::bf16_t*)(ws + WS_R2 + R2_H2), (const pg8::bf16_t*)(wl + W_UP_OFF), NTOK, DUP, DMODEL}; pg8::StaticOrder S; S.init(NTOK, DUP, F.G, (int)blockIdx.x);
            pg8::EpiUp E{ssq + (size_t)(l == 0 ? 0 : 2) * NTOK, (const float*)(ws + WS_CTL + CTL_CUP) + (size_t)l * 3 * DUP, (pg8::bf16_t*)(ws + WS_R1)};
            pg8::gemm_phase<pg8::EpiUp, pg8::StaticOrder, true, true>(F.lds + RING_OFF, g, S, E);
        } SEAM(pb + 3);
        if (IN(pb + 4)) { conv_phase(F, l); } SEAM(pb + 4);
        if (IN(pb + 5)) {
            pg8::Gemm g{(const pg8::bf16_t*)(ws + WS_R2), (const pg8::bf16_t*)(wl + W_DOWN_OFF), NTOK, DMODEL, DFF}; pg8::StaticOrder S; S.init(NTOK, DMODEL, F.G, (int)blockIdx.x);
            const bool more = (l + 1 < DEPTH);
            pg8::EpiRes E{F.out, F.out + (size_t)NPROMPT * DMODEL, F.out, ml + 5120, more ? F.in[12] + (l + 1) * DMODEL : nullptr, more ? ml + 3 * 6144 + 1024 : nullptr,
                          more ? (pg8::bf16_t*)(ws + WS_R1 + R1_H1) : nullptr, ssq + (size_t)(l == 0 ? 1 : 3) * NTOK};
            pg8::gemm_phase<pg8::EpiRes, pg8::StaticOrder, true, true>(F.lds + RING_OFF, g, S, E);
        } SEAM(pb + 5);
    }
    if (IN(N_PHASES - 1)) final_phase(F);
#undef IN
#undef SEAM
}

extern "C" void kernel_launch(void* const* d_in, const int* in_sizes, int n_in, void* d_out, int out_size, void* d_ws, size_t ws_size, hipStream_t stream) {
    static int grid = 0;
    if (grid == 0) {
        if (n_in != 29 || out_size != (int)pg8::O_TOTAL || ws_size < WS_END) { fprintf(stderr, "kernel_launch: unexpected shapes (n_in %d, out %d, ws %zu); nothing launched\n", n_in, out_size, ws_size); grid = -1; return; }
        int dev = 0, cus = 0, per_cu = 0;
        if (hipGetDevice(&dev) != hipSuccess || hipDeviceGetAttribute(&cus, hipDeviceAttributeMultiprocessorCount, dev) != hipSuccess) { grid = -1; return; }
        if (hipFuncSetAttribute((const void*)fwd_kernel, hipFuncAttributeMaxDynamicSharedMemorySize, LDS_BYTES) != hipSuccess) { fprintf(stderr, "kernel_launch: hipFuncSetAttribute failed\n"); grid = -1; return; }
        if (hipOccupancyMaxActiveBlocksPerMultiprocessor(&per_cu, (const void*)fwd_kernel, NWAVES * 64, LDS_BYTES) != hipSuccess || per_cu < 1) { fprintf(stderr, "kernel_launch: occupancy query reports %d blocks per CU\n", per_cu); }
        (void)hipGetLastError();
        grid = cus;
    }
    if (grid < 0) return;
    if (hipMemsetAsync((char*)d_ws + WS_CTL, 0, CTL_ZERO_BYTES, stream) != hipSuccess) return;
    Args a{};
    for (int i = 0; i < 29; ++i) a.in[i] = (const float*)d_in[i];
    a.out = (float*)d_out; a.ws = (unsigned char*)d_ws;
    if (MK_N_LAUNCHES == 1) { a.ph_lo = 0; a.ph_hi = N_PHASES; hipLaunchKernelGGL(fwd_kernel, dim3(grid), dim3(NWAVES * 64), LDS_BYTES, stream, a); }
    else for (int p = 0; p < N_PHASES; ++p) { a.ph_lo = p; a.ph_hi = p + 1; hipLaunchKernelGGL(fwd_kernel, dim3(grid), dim3(NWAVES * 64), LDS_BYTES, stream, a); }
}
```

```cpp
#ifndef MK_N_LAUNCHES
#define MK_N_LAUNCHES 1
#endif
#include <hip/hip_runtime.h>
#include <cstdio>
#include <cstdint>
namespace pg8 {
#define PG8_LAS __attribute__((address_space(3)))
typedef unsigned short bf16_t;
typedef short bf16x8 __attribute__((ext_vector_type(8)));
typedef float f32x4 __attribute__((ext_vector_type(4)));
typedef unsigned u32x4 __attribute__((ext_vector_type(4)));
constexpr int BM = 256, BK = 64, HALF = 128, HTB = HALF * BK * 2  , STAGE_BYTES = 8 * HTB, NXCD = 8, WGM = 8;

__host__ __device__ __forceinline__ int lds_byte(int r, int c) { const int st = (r >> 4) * 2 + (c >> 5), rr = r & 15, cc = c & 31, ob = rr * 64 + cc * 2; return st * 1024 + (ob ^ (((ob >> 9) & 1) << 5)); }
__host__ __device__ __forceinline__ void stage_rc(int b, int& R, int& C) { const int st = b / 1024, sb = b % 1024, swz = sb ^ (((sb >> 9) & 1) << 5); R = (st >> 1) * 16 + swz / 64; C = (st & 1) * 32 + (swz % 64) / 2; }
__host__ __device__ __forceinline__ int perm32(int rho) { const int n = rho >> 4, i = rho & 15; return 8 * (i >> 2) + 4 * n + (i & 3); }

struct Unit { int pm, pn; };
struct Gemm { const bf16_t* A; const bf16_t* Bt; int M, N, K; };

struct StaticOrder {
    int nM, nN, nwg, G, c;
    __host__ __device__ void init(int M, int N, int G_, int c_) { nM = M / BM; nN = N / BM; nwg = nM * nN; G = G_; c = c_; }
    __host__ __device__ bool next(int i, Unit& u) const {
        const long L = (long)i * G + c; if (L >= nwg) return false;
        int wgid = (int)L; { const int q = nwg / NXCD, r = nwg % NXCD, xcd = wgid % NXCD, off = wgid / NXCD; wgid = (xcd < r ? xcd * (q + 1) : r * (q + 1) + (xcd - r) * q) + off; }
        const int nig = WGM * nN, gid = wgid / nig, fm = gid * WGM, gsz = (nM - fm) < WGM ? (nM - fm) : WGM;
        u.pm = fm + ((wgid % nig) % gsz); u.pn = (wgid % nig) / gsz; return true;
    }
    __device__ __forceinline__ void a_ready(const Unit&) const {}
    __device__ __forceinline__ void done(const Unit&) const {}
};
__device__ __forceinline__ unsigned cvt_pk_bf16(float lo, float hi) { unsigned r; asm volatile("v_cvt_pk_bf16_f32 %0, %1, %2" : "=v"(r) : "v"(lo), "v"(hi)); return r; }
typedef unsigned u32x2 __attribute__((ext_vector_type(2)));
constexpr float RMS_EPS = 1e-6f, LOG2E = 1.4426950408889634f;
constexpr float C2_64 = 0.125f * LOG2E, C2_32 = 0.17677669529663687f * LOG2E;
constexpr int NTOK = 12288, NPROMPT = 4096;
constexpr long KA_S = 0, VA_S = 1114112, KB_S = 2228224, VB_S = 3342336, KC_S = 4456448, VC_S = 6684672,
               KA_P = 8912896, VA_P = 9437184, KB_P = 9961472, VB_P = 10485760, KC_P = 11010048, VC_P = 12058624, KV_ELEMS = 13107200;
constexpr long O_NAK = 12582912, O_NAV = 13631488, O_NBK = 14680064, O_NBV = 15728640, O_NCK = 16777216, O_NCV = 18874368, O_TOTAL = 20971520;

struct EpiIn {
    static constexpr bool PERM = false, AFTER_DRAIN = false, APERM = false;
    int layer; const float* sumsq; const float* cin; const float* gqa; const float* gka; const float* rope; bf16_t* Q; bf16_t* KV; float* out;
    __device__ __forceinline__ void operator()(const f32x4 (&acc)[2][2][4][2], const Unit& u, int wr, int wc, int fr, int fq) const {
        const int g = u.pn * 4 + wc;
        const bool smp = u.pm >= 16;
        const int sq = smp ? ((u.pm - 16) >> 4) : u.pm;
        const int t0 = smp ? ((u.pm - 16) & 15) * 256 : 0;
        const int cond = smp ? 1 + sq : 0;
        int mix, kind, hh;
        if (g < 6) { mix = 0; kind = 0; hh = g; } else if (g < 8) { mix = 0; kind = 1; hh = g - 6; } else if (g < 10) { mix = 0; kind = 2; hh = g - 8; }
        else if (g < 16) { mix = 1; kind = 0; hh = g - 10; } else if (g < 18) { mix = 1; kind = 1; hh = g - 16; } else if (g < 20) { mix = 1; kind = 2; hh = g - 18; }
        else if (g < 24) { mix = 2; kind = 0; hh = g - 20; } else if (g < 28) { mix = 2; kind = 1; hh = g - 24; } else { mix = 2; kind = 2; hh = g - 28; }
        const bool c32 = (mix == 2) && (kind != 2);
        const int nst = c32 ? 8 : 16;
        const int dlo = c32 ? (16 * (fq >> 1) + 4 * (fq & 1)) : 4 * fq;
        bf16_t* dst; long dpitch, drow0; float* fo = nullptr; long forow0 = 0;
        if (kind == 0) { dst = Q + (mix == 0 ? 0 : mix == 1 ? 384 : 768) + hh * 64; dpitch = 1024; drow0 = (long)u.pm * 256; }
        else {
            dpitch = (mix == 2) ? 256 : 128;
            long off;
            if (smp) { off = mix == 0 ? (kind == 1 ? KA_S : VA_S) : mix == 1 ? (kind == 1 ? KB_S : VB_S) : (kind == 1 ? KC_S : VC_S); drow0 = (long)sq * 4352 + 256 + t0; }
            else { off = mix == 0 ? (kind == 1 ? KA_P : VA_P) : mix == 1 ? (kind == 1 ? KB_P : VB_P) : (kind == 1 ? KC_P : VC_P); drow0 = (long)sq * 256;
                   fo = out + (mix == 0 ? (kind == 1 ? O_NAK : O_NAV) : mix == 1 ? (kind == 1 ? O_NBK : O_NBV) : (kind == 1 ? O_NCK : O_NCV)) + hh * 64; forow0 = ((long)sq * 2 + layer) * 256; }
            dst = KV + off + hh * 64;
        }
        const bool nrm = (mix == 0) && (kind < 2);
        const bool rp = smp && (kind < 2);
        const float qs = (kind == 0) ? (mix == 2 ? C2_32 : C2_64) : 1.0f;
        f32x4 cv[2][2];
        const float* cp = cin + cond * 2048 + g * 64 + dlo;
        const float* gp = ((kind == 0) ? gqa : gka) + 4 * fq;
#pragma unroll
        for (int bj = 0; bj < 2; ++bj)
#pragma unroll
            for (int n = 0; n < 2; ++n) cv[bj][n] = *(const f32x4*)(cp + 32 * bj + nst * n);
        const float* ssp = sumsq + u.pm * BM + wr * 64 + fr;
        bf16_t* dstb = dst + (drow0 + wr * 64 + fr) * dpitch + dlo;
        float* fob = fo ? fo + (forow0 + wr * 64 + fr) * dpitch + dlo : nullptr;
        const float* rrow = c32 ? rope + 2048 + ((t0 >> 6) + wr) * 8 + 4 * (fq & 1) : rope + ((t0 >> 6) + wr) * 16 + 4 * fq;
        const float* rcol = c32 ? rope + 2048 + fr * 8 + 4 * (fq & 1) : rope + fr * 16 + 4 * fq;
        const int rst = c32 ? 8 : 16, sof = c32 ? 512 : 1024;
#pragma unroll
        for (int ai = 0; ai < 2; ++ai)
#pragma unroll
            for (int m = 0; m < 4; ++m) {
                const float rstd = rsqrtf(ssp[ai * HALF + m * 16] * (1.0f / 1024.0f) + RMS_EPS);
                f32x4 v[2][2];
#pragma unroll
                for (int bj = 0; bj < 2; ++bj)
#pragma unroll
                    for (int n = 0; n < 2; ++n) v[bj][n] = acc[ai][bj][m][n] * rstd + cv[bj][n];
                if (nrm) {
                    float ss = 0.f;
#pragma unroll
                    for (int bj = 0; bj < 2; ++bj)
#pragma unroll
                        for (int n = 0; n < 2; ++n) { const f32x4 x = v[bj][n]; ss += (x[0] * x[0] + x[1] * x[1]) + (x[2] * x[2] + x[3] * x[3]); }
                    ss += __shfl_xor(ss, 16); ss += __shfl_xor(ss, 32);
                    const float rn = rsqrtf(ss * (1.0f / 64.0f) + RMS_EPS);
#pragma unroll
                    for (int bj = 0; bj < 2; ++bj)
#pragma unroll
                        for (int n = 0; n < 2; ++n) v[bj][n] = v[bj][n] * rn * (*(const f32x4*)(gp + 32 * bj + 16 * n));
                }
                if (fo) {
#pragma unroll
                    for (int bj = 0; bj < 2; ++bj)
#pragma unroll
                        for (int n = 0; n < 2; ++n) *(f32x4*)(fob + (long)(ai * HALF + m * 16) * dpitch + 32 * bj + nst * n) = v[bj][n];
                }
                if (rp) {
#pragma unroll
                    for (int bj = 0; bj < 2; ++bj) {
                        const bool colpart = c32 ? (fq >> 1) != 0 : (bj != 0);
                        const float* cs = colpart ? rcol + m * 16 * rst : rrow + 2 * ai * rst;
                        const f32x4 c = *(const f32x4*)cs, sn = *(const f32x4*)(cs + sof);
                        const f32x4 x1 = v[bj][0], x2 = v[bj][1];
                        v[bj][0] = x1 * c - x2 * sn; v[bj][1] = x2 * c + x1 * sn;
                    }
                }
#pragma unroll
                for (int bj = 0; bj < 2; ++bj)
#pragma unroll
                    for (int n = 0; n < 2; ++n) { const f32x4 w = v[bj][n] * qs; u32x2 pk; pk.x = cvt_pk_bf16(w[0], w[1]); pk.y = cvt_pk_bf16(w[2], w[3]);
                        *(u32x2*)(dstb + (long)(ai * HALF + m * 16) * dpitch + 32 * bj + nst * n) = pk; }
                asm volatile("" ::: "memory");
            }
    }
};

struct EpiRes {
    static constexpr bool PERM = false, AFTER_DRAIN = false, APERM = false;
    const float* src_p; const float* src_s; float* X; const float* gate; const float* gn; const float* scn; bf16_t* H; float* sumsq;
    __device__ __forceinline__ void operator()(const f32x4 (&acc)[2][2][4][2], const Unit& u, int wr, int wc, int fr, int fq) const {
        const bool smp = u.pm >= 16; const int cond = smp ? 1 + ((u.pm - 16) >> 4) : 0;
        const float* src = smp ? src_s + ((long)u.pm * BM - NPROMPT) * 1024 : src_p + (long)u.pm * BM * 1024;
        float* xo = X + (long)u.pm * BM * 1024; bf16_t* ho = H ? H + (long)u.pm * BM * 1024 : nullptr;
        const int col0 = u.pn * BM + wc * 32 + 4 * fq;
        f32x4 gt[2][2], gm[2][2];
#pragma unroll
        for (int bj = 0; bj < 2; ++bj)
#pragma unroll
            for (int n = 0; n < 2; ++n) { const int c = col0 + bj * HALF + n * 16; gt[bj][n] = *(const f32x4*)(gate + cond * 6144 + c);
                gm[bj][n] = H ? *(const f32x4*)(gn + c) * (*(const f32x4*)(scn + cond * 6144 + c) + 1.0f) : (f32x4){0.f, 0.f, 0.f, 0.f}; }
#pragma unroll
        for (int ai = 0; ai < 2; ++ai)
#pragma unroll
            for (int m = 0; m < 4; ++m) {
                const int rloc = ai * HALF + wr * 64 + m * 16 + fr; float ss = 0.f;
#pragma unroll
                for (int bj = 0; bj < 2; ++bj)
#pragma unroll
                    for (int n = 0; n < 2; ++n) { const long off = (long)rloc * 1024 + col0 + bj * HALF + n * 16;
                        const f32x4 x1 = *(const f32x4*)(src + off) + gt[bj][n] * acc[ai][bj][m][n]; *(f32x4*)(xo + off) = x1;
                        ss += (x1[0] * x1[0] + x1[1] * x1[1]) + (x1[2] * x1[2] + x1[3] * x1[3]);
                        if (H) { const f32x4 w = x1 * gm[bj][n]; u32x2 pk; pk.x = cvt_pk_bf16(w[0], w[1]); pk.y = cvt_pk_bf16(w[2], w[3]); *(u32x2*)(ho + off) = pk; } }
                ss += __shfl_xor(ss, 16); ss += __shfl_xor(ss, 32);
                if (fq == 0) unsafeAtomicAdd(sumsq + u.pm * BM + rloc, ss);
            }
    }
};

__device__ __forceinline__ float dpp_shr1(float x) { return __int_as_float(__builtin_amdgcn_update_dpp(0, __float_as_int(x), 0x111, 0xf, 0xf, true)); }
__device__ __forceinline__ float dpp_shl1(float x) { return __int_as_float(__builtin_amdgcn_update_dpp(0, __float_as_int(x), 0x101, 0xf, 0xf, true)); }
__device__ __forceinline__ float silu_e(float x) { return x * __builtin_amdgcn_rcpf(1.0f + __expf(-x)); }
struct EpiUpConv {
    static constexpr bool PERM = false, AFTER_DRAIN = false, APERM = true;
    const float* sumsq; const float* cup; const float* cw; const float* cb; bf16_t* ACT; float* halo;
    __device__ __forceinline__ void operator()(const f32x4 (&acc)[2][2][4][2], const Unit& u, int wr, int wc, int fr, int fq) const {
        const bool smp = u.pm >= 16; const int cond = smp ? 1 + ((u.pm - 16) >> 4) : 0;
        const long tok0 = (long)u.pm * BM + 128 * wr + 8 * fr;
        const int ch0 = 128 * u.pn + 32 * wc + 8 * fq;
        float r[8];
        { const f32x4 s0 = *(const f32x4*)(sumsq + tok0), s1 = *(const f32x4*)(sumsq + tok0 + 4);
#pragma unroll
          for (int k = 0; k < 4; ++k) { r[k] = rsqrtf(s0[k] * (1.0f / 1024.0f) + RMS_EPS); r[4 + k] = rsqrtf(s1[k] * (1.0f / 1024.0f) + RMS_EPS); } }
        unsigned pk[8][2][2];
        float* hb = halo + ((long)(u.pm * 2 + wr) * 4) * 5632 + ch0;
#pragma unroll
        for (int n = 0; n < 2; ++n) {
            const int ch = ch0 + 4 * n;
            const f32x4 ca = *(const f32x4*)(cup + cond * 5632 + ch), cg = *(const f32x4*)(cup + cond * 5632 + 2816 + ch);
            const f32x4 w0a = *(const f32x4*)(cw + ch), w1a = *(const f32x4*)(cw + 5632 + ch), w2a = *(const f32x4*)(cw + 2 * 5632 + ch), ba = *(const f32x4*)(cb + ch);
            const f32x4 w0g = *(const f32x4*)(cw + 2816 + ch), w1g = *(const f32x4*)(cw + 5632 + 2816 + ch), w2g = *(const f32x4*)(cw + 2 * 5632 + 2816 + ch), bg = *(const f32x4*)(cb + 2816 + ch);
            f32x4 ua[8], ug[8];
#pragma unroll
            for (int k = 0; k < 8; ++k) { ua[k] = acc[k >> 2][0][k & 3][n] * r[k] + ca; ug[k] = acc[k >> 2][1][k & 3][n] * r[k] + cg; }
            f32x4 pa, na, pg, ng;
#pragma unroll
            for (int j = 0; j < 4; ++j) { pa[j] = dpp_shr1(ua[7][j]); na[j] = dpp_shl1(ua[0][j]); pg[j] = dpp_shr1(ug[7][j]); ng[j] = dpp_shl1(ug[0][j]); }
            if (fr == 0) { *(f32x4*)(hb + 4 * n) = ua[0]; *(f32x4*)(hb + 2816 + 4 * n) = ug[0]; *(f32x4*)(hb + 5632 + 4 * n) = ua[1]; *(f32x4*)(hb + 5632 + 2816 + 4 * n) = ug[1]; }
            if (fr == 15) { *(f32x4*)(hb + 2 * 5632 + 4 * n) = ua[6]; *(f32x4*)(hb + 2 * 5632 + 2816 + 4 * n) = ug[6]; *(f32x4*)(hb + 3 * 5632 + 4 * n) = ua[7]; *(f32x4*)(hb + 3 * 5632 + 2816 + 4 * n) = ug[7]; }
#pragma unroll
            for (int k = 0; k < 8; ++k) {
                const f32x4 av = w0a * (k ? ua[k > 0 ? k - 1 : 0] : pa) + w1a * ua[k] + w2a * (k < 7 ? ua[k < 7 ? k + 1 : 7] : na) + ba;
                const f32x4 gv = w0g * (k ? ug[k > 0 ? k - 1 : 0] : pg) + w1g * ug[k] + w2g * (k < 7 ? ug[k < 7 ? k + 1 : 7] : ng) + bg;
                pk[k][n][0] = cvt_pk_bf16(silu_e(av[0]) * gv[0], silu_e(av[1]) * gv[1]); pk[k][n][1] = cvt_pk_bf16(silu_e(av[2]) * gv[2], silu_e(av[3]) * gv[3]);
            }
        }
        bf16_t* ap = ACT + tok0 * 2816 + ch0;
#pragma unroll
        for (int k = 0; k < 8; ++k) { u32x4 w; w.x = pk[k][0][0]; w.y = pk[k][0][1]; w.z = pk[k][1][0]; w.w = pk[k][1][1];
            if (!((k == 0 && fr == 0) || (k == 7 && fr == 15))) *(u32x4*)(ap + (long)k * 2816) = w; }
    }
};

template <class Epi, class Sched, bool ALIGN_EPI = false, bool SP2 = false>
__device__ __forceinline__ void gemm_phase(PG8_LAS unsigned char* lds, const Gemm g, const Sched& S, const Epi& E) {
    int tid_ = threadIdx.x; asm volatile("" : "+v"(tid_));
    const int tid = tid_, wid = __builtin_amdgcn_readfirstlane(tid >> 6), lane = tid & 63, wr = wid >> 2, wc = wid & 3, fr = lane & 15, fq = lane >> 4;
    const int K = g.K, nt = K / BK;
    unsigned voffA[2], voffB[2];
#pragma unroll
    for (int i = 0; i < 2; ++i) { int R, C; stage_rc(tid * 16 + i * 8192, R, C); const int Rb = Epi::PERM ? ((R & ~31) + perm32(R & 31)) : R;
        const int Ra = Epi::APERM ? (128 * (R >> 6) + 8 * (R & 15) + ((R >> 4) & 3)) : R; voffA[i] = (unsigned)(Ra * K + C) * 2u; voffB[i] = (unsigned)(Rb * K + C) * 2u; }
    const size_t kstep = (size_t)(BK * 2);
    const size_t hstep = (size_t)HALF * K * 2;
    const size_t tstep = 2 * hstep; const size_t hstepA = Epi::APERM ? (size_t)4 * K * 2 : hstep;
    const unsigned ldsw = (unsigned)wid * 1024u;
    const int aoff = lds_byte(wr * 64 + fr, fq * 8), boff = lds_byte(wc * 32 + fr, fq * 8);
#define PG8_SA(b, h) (((b) * 2 + (h)) * HTB)
#define PG8_SB(b, h) ((4 + (b) * 2 + (h)) * HTB)
#define PG8_STAGE(bufoff, gbase, voff) do { _Pragma("unroll") for (int _i = 0; _i < 2; ++_i) \
        __builtin_amdgcn_global_load_lds((const unsigned*)((const char*)(gbase) + (voff)[_i]), (PG8_LAS unsigned*)(lds + (bufoff) + ldsw + _i * 8192), 16, 0, 0); } while (0)
#define PG8_LDA(dst, b, h) do { _Pragma("unroll") for (int m = 0; m < 4; ++m) _Pragma("unroll") for (int k = 0; k < 2; ++k) dst[m][k] = *(const PG8_LAS bf16x8*)(lds + PG8_SA(b, h) + aoff + m * 2048 + k * 1024); } while (0)
#define PG8_LDB(dst, b, h) do { _Pragma("unroll") for (int n = 0; n < 2; ++n) _Pragma("unroll") for (int k = 0; k < 2; ++k) dst[n][k] = *(const PG8_LAS bf16x8*)(lds + PG8_SB(b, h) + boff + n * 2048 + k * 1024); } while (0)
#define PG8_MMA(ai, bj, At, Bt) do { __builtin_amdgcn_s_setprio(1); _Pragma("unroll") for (int m = 0; m < 4; ++m) _Pragma("unroll") for (int n = 0; n < 2; ++n) _Pragma("unroll") for (int k = 0; k < 2; ++k) \
        acc[ai][bj][m][n] = __builtin_amdgcn_mfma_f32_16x16x32_bf16(Bt[n][k], At[m][k], acc[ai][bj][m][n], 0, 0, 0); __builtin_amdgcn_s_setprio(0); } while (0)
#define PG8_WAIT_V(n) asm volatile("s_waitcnt vmcnt(" #n ")" ::: "memory")
#define PG8_WAIT_L(n) asm volatile("s_waitcnt lgkmcnt(" #n ")" ::: "memory")
#define PG8_BAR __builtin_amdgcn_s_barrier()
#define PG8_SCHED __builtin_amdgcn_sched_barrier(0)
    Unit cur, nxt; int ui = 0;
    if (!S.next(0, cur)) return;
    f32x4 acc[2][2][4][2];
#pragma unroll
    for (int a = 0; a < 2; ++a)
#pragma unroll
        for (int b = 0; b < 2; ++b)
#pragma unroll
            for (int m = 0; m < 4; ++m)
#pragma unroll
                for (int n = 0; n < 2; ++n) acc[a][b][m][n] = (f32x4){0.f, 0.f, 0.f, 0.f};
    bf16x8 At[4][2], B0[2][2], B1[2][2];
    const char* cA = (const char*)g.A + (size_t)cur.pm * tstep; const char* cB = (const char*)g.Bt + (size_t)cur.pn * tstep;
    S.a_ready(cur);
    if constexpr (SP2) {
        PG8_STAGE(PG8_SB(0, 0), cB, voffB); PG8_STAGE(PG8_SB(0, 1), cB + hstep, voffB); PG8_STAGE(PG8_SA(0, 0), cA, voffA); PG8_STAGE(PG8_SA(0, 1), cA + hstepA, voffA);
        if (wr == 1) PG8_BAR;
        PG8_WAIT_V(2); PG8_BAR;
        PG8_STAGE(PG8_SB(1, 0), cB + kstep, voffB); PG8_STAGE(PG8_SA(1, 0), cA + kstep, voffA); PG8_STAGE(PG8_SB(1, 1), cB + hstep + kstep, voffB);
        PG8_WAIT_V(6); PG8_BAR;
    } else {
        PG8_STAGE(PG8_SB(0, 0), cB, voffB); PG8_STAGE(PG8_SA(0, 0), cA, voffA); PG8_STAGE(PG8_SB(0, 1), cB + hstep, voffB); PG8_STAGE(PG8_SA(0, 1), cA + hstepA, voffA);
        if (wr == 1) PG8_BAR;
        PG8_WAIT_V(4); PG8_BAR;
        PG8_STAGE(PG8_SB(1, 0), cB + kstep, voffB); PG8_STAGE(PG8_SA(1, 0), cA + kstep, voffA); PG8_STAGE(PG8_SB(1, 1), cB + hstep + kstep, voffB);
        PG8_WAIT_V(6); PG8_BAR;
    }
    for (;;) {
        const bool has_next = S.next(ui + 1, nxt);
        const char* nA = has_next ? (const char*)g.A + (size_t)nxt.pm * tstep : cA; const char* nB = has_next ? (const char*)g.Bt + (size_t)nxt.pn * tstep : cB;
        for (int t = 0; t < nt; t += 2) {
            const bool last = (t == nt - 2);
            const char* a1 = cA + (size_t)(t + 1) * kstep;
            const char* a2 = last ? nA : cA + (size_t)(t + 2) * kstep; const char* b2 = last ? nB : cB + (size_t)(t + 2) * kstep;
            const char* a3 = a2 + kstep; const char* b3 = b2 + kstep;
            if (last && has_next) S.a_ready(nxt);
            if constexpr (SP2) {
            PG8_LDB(B0, 0, 0); PG8_LDB(B1, 0, 1); PG8_SCHED; PG8_LDA(At, 0, 0); PG8_STAGE(PG8_SA(1, 1), a1 + hstepA, voffA);
            PG8_WAIT_V(8); PG8_WAIT_L(0); PG8_BAR; PG8_MMA(0, 0, At, B0); PG8_MMA(0, 1, At, B1); PG8_BAR; PG8_SCHED;
            PG8_LDA(At, 0, 1); PG8_STAGE(PG8_SB(0, 0), b2, voffB); PG8_STAGE(PG8_SB(0, 1), b2 + hstep, voffB); PG8_STAGE(PG8_SA(0, 0), a2, voffA);
            PG8_WAIT_V(8); PG8_WAIT_L(0); PG8_BAR; PG8_MMA(1, 0, At, B0); PG8_MMA(1, 1, At, B1); PG8_BAR; PG8_SCHED;
            PG8_LDB(B0, 1, 0); PG8_LDB(B1, 1, 1); PG8_SCHED; PG8_LDA(At, 1, 0); PG8_STAGE(PG8_SA(0, 1), a2 + hstepA, voffA);
            PG8_WAIT_V(8); PG8_WAIT_L(0); PG8_BAR; PG8_MMA(0, 0, At, B0); PG8_MMA(0, 1, At, B1); PG8_BAR; PG8_SCHED;
            PG8_LDA(At, 1, 1); PG8_STAGE(PG8_SB(1, 0), b3, voffB); PG8_STAGE(PG8_SB(1, 1), b3 + hstep, voffB); PG8_STAGE(PG8_SA(1, 0), a3, voffA);
            PG8_WAIT_V(8); PG8_WAIT_L(0); PG8_BAR; PG8_MMA(1, 0, At, B0); PG8_MMA(1, 1, At, B1); PG8_BAR; PG8_SCHED;
            } else {
            PG8_LDB(B0, 0, 0); PG8_SCHED; PG8_LDA(At, 0, 0); PG8_STAGE(PG8_SA(1, 1), a1 + hstepA, voffA);
            PG8_WAIT_L(8); PG8_BAR; PG8_WAIT_L(0); PG8_MMA(0, 0, At, B0); PG8_BAR; PG8_SCHED;
            PG8_LDB(B1, 0, 1); PG8_STAGE(PG8_SB(0, 0), b2, voffB);
            PG8_BAR; PG8_WAIT_L(0); PG8_MMA(0, 1, At, B1); PG8_BAR;
            PG8_LDA(At, 0, 1); PG8_STAGE(PG8_SA(0, 0), a2, voffA);
            PG8_BAR; PG8_WAIT_L(0); PG8_MMA(1, 0, At, B0); PG8_BAR; PG8_SCHED;
            PG8_STAGE(PG8_SB(0, 1), b2 + hstep, voffB);
            PG8_WAIT_V(6); PG8_BAR; PG8_MMA(1, 1, At, B1); PG8_BAR;
            PG8_LDB(B0, 1, 0); PG8_SCHED; PG8_LDA(At, 1, 0); PG8_STAGE(PG8_SA(0, 1), a2 + hstepA, voffA);
            PG8_WAIT_L(8); PG8_BAR; PG8_WAIT_L(0); PG8_MMA(0, 0, At, B0); PG8_BAR; PG8_SCHED;
            PG8_LDB(B1, 1, 1); PG8_STAGE(PG8_SB(1, 0), b3, voffB);
            PG8_BAR; PG8_WAIT_L(0); PG8_MMA(0, 1, At, B1); PG8_BAR;
            PG8_LDA(At, 1, 1); PG8_STAGE(PG8_SA(1, 0), a3, voffA);
            PG8_BAR; PG8_WAIT_L(0); PG8_MMA(1, 0, At, B0); PG8_BAR; PG8_SCHED;
            PG8_STAGE(PG8_SB(1, 1), b3 + hstep, voffB);
            PG8_WAIT_V(6); PG8_BAR; PG8_MMA(1, 1, At, B1); PG8_BAR;
            }
        }
        if constexpr (ALIGN_EPI) { if (wr == 0) PG8_BAR; }
        if constexpr (!Epi::AFTER_DRAIN) { E(acc, cur, wr, wc, fr, fq); S.done(cur); }
        if (!has_next) break;
#pragma unroll
        for (int a = 0; a < 2; ++a)
#pragma unroll
            for (int b = 0; b < 2; ++b)
#pragma unroll
                for (int m = 0; m < 4; ++m)
#pragma unroll
                    for (int n = 0; n < 2; ++n) acc[a][b][m][n] = (f32x4){0.f, 0.f, 0.f, 0.f};
        cur = nxt; cA = nA; cB = nB; ++ui;
        if constexpr (ALIGN_EPI) { if (wr == 1) PG8_BAR; }
    }
    PG8_WAIT_V(0);
    if constexpr (!ALIGN_EPI) { if (wr == 0) PG8_BAR; }
    PG8_BAR;
    if constexpr (Epi::AFTER_DRAIN) { E.fused(acc, cur, wr, wc, fr, fq, lds, wid, lane); S.done(cur); }
#undef PG8_SA
#undef PG8_SB
#undef PG8_STAGE
#undef PG8_LDA
#undef PG8_LDB
#undef PG8_MMA
#undef PG8_WAIT_V
#undef PG8_WAIT_L
#undef PG8_BAR
#undef PG8_SCHED
}
}
#include <hip/hip_bf16.h>
#include <cmath>
namespace attn_body {
using bf16=__hip_bfloat16;
using bf16x8=__attribute__((ext_vector_type(8)))short;
using s16x4=__attribute__((ext_vector_type(4)))short;
using f32x16=__attribute__((ext_vector_type(16)))float;
using u32x4=__attribute__((ext_vector_type(4)))unsigned;
using f32x4=__attribute__((ext_vector_type(4)))float;
using u32x2=__attribute__((ext_vector_type(2)))unsigned;
constexpr int D=64,QP=1024;
constexpr int NW=8,QBLK=32,QB=QBLK*NW,KVBLK=64;
__device__ __forceinline__ int crow(int r,int hi){return (r&3)+8*(r>>2)+4*hi;}
#define SBAR() __builtin_amdgcn_sched_barrier(0)
__device__ __forceinline__ void bmask(f32x16&p0,f32x16&p1,int dlt,int hi){
  const float NEG=-INFINITY; const int kb=dlt+4*hi;
  #pragma unroll
  for(int r=0;r<16;++r){const int kv=kb+(r&3)+8*(r>>2); if(kv>128||kv<-128)p0[r]=NEG; if(kv+32>128||kv+32<-128)p1[r]=NEG;}
}

constexpr int NSLOT=3, SLOTB=8192;
constexpr int LDS_K=0, LDS_V=NSLOT*SLOTB, LDS_WS=2*NSLOT*SLOTB, LDS_OST=LDS_WS+NW*64*4, LDS_BYTES=LDS_OST+NW*8192;
__device__ __forceinline__ void glds16(const void*gsrc,unsigned lds_dst){unsigned keep;
  asm volatile("s_mov_b32 %0, m0\n\ts_mov_b32 m0, %2\n\ts_nop 0\n\tglobal_load_lds_dwordx4 %1, off\n\ts_mov_b32 m0, %0":"=&s"(keep):"v"(gsrc),"s"(lds_dst):"memory");}
__device__ __forceinline__ float max3f(float a,float b,float c){float r;asm("v_max3_f32 %0, %1, %2, %3":"=v"(r):"v"(a),"v"(b),"v"(c));return r;}
__device__ __forceinline__ float max2f(float a,float b){float r;asm("v_max_f32_e32 %0, %1, %2":"=v"(r):"v"(a),"v"(b));return r;}
__device__ __forceinline__ float fadd_s(float a,float b){float r;asm("v_add_f32_e32 %0, %1, %2":"=v"(r):"v"(a),"v"(b));return r;}
__device__ __forceinline__ float fsub_s(float a,float b){float r;asm("v_sub_f32_e32 %0, %1, %2":"=v"(r):"v"(a),"v"(b));return r;}
typedef float f32x2_t __attribute__((ext_vector_type(2))); typedef __bf16 bf16x2_t __attribute__((ext_vector_type(2)));
__device__ __forceinline__ unsigned cvtpk_s(float lo,float hi){f32x2_t v={lo,hi};bf16x2_t b=__builtin_convertvector(v,bf16x2_t);return __builtin_bit_cast(unsigned,b);}
#define WAIT_BAR(N) asm volatile("s_waitcnt vmcnt(" #N ") lgkmcnt(0)\n\ts_barrier":::"memory")

__device__ __forceinline__ void qkt(f32x16&p0,f32x16&p1,const char*Kslot,const bf16x8*qr,const f32x16&negm,int r32,int hi){
  const char*kb=Kslot+hi*1024+r32*16;
  #pragma unroll
  for(int d0=0;d0<4;++d0){
    const bf16x8 b0=*reinterpret_cast<const bf16x8*>(kb+d0*2048);
    const bf16x8 b1=*reinterpret_cast<const bf16x8*>(kb+d0*2048+512);
    if(d0==0){p0=__builtin_amdgcn_mfma_f32_32x32x16_bf16(b0,qr[0],negm,0,0,0);p1=__builtin_amdgcn_mfma_f32_32x32x16_bf16(b1,qr[0],negm,0,0,0);}
    else{p0=__builtin_amdgcn_mfma_f32_32x32x16_bf16(b0,qr[d0],p0,0,0,0);p1=__builtin_amdgcn_mfma_f32_32x32x16_bf16(b1,qr[d0],p1,0,0,0);}}
}
typedef __attribute__((address_space(3))) const char* lds_cptr;
typedef short v4i16_t __attribute__((ext_vector_type(4)));
__device__ __forceinline__ void kload8(bf16x8*kf,lds_cptr kp){
  kf[0]=*(const __attribute__((address_space(3))) bf16x8*)(kp);      kf[1]=*(const __attribute__((address_space(3))) bf16x8*)(kp+512);
  kf[2]=*(const __attribute__((address_space(3))) bf16x8*)(kp+2048); kf[3]=*(const __attribute__((address_space(3))) bf16x8*)(kp+2560);
  kf[4]=*(const __attribute__((address_space(3))) bf16x8*)(kp+4096); kf[5]=*(const __attribute__((address_space(3))) bf16x8*)(kp+4608);
  kf[6]=*(const __attribute__((address_space(3))) bf16x8*)(kp+6144); kf[7]=*(const __attribute__((address_space(3))) bf16x8*)(kp+6656);
}
__device__ __forceinline__ void kload2(bf16x8*kf,lds_cptr kp,int j){ kf[2*j]=*(const __attribute__((address_space(3))) bf16x8*)(kp+j*2048); kf[2*j+1]=*(const __attribute__((address_space(3))) bf16x8*)(kp+j*2048+512); }
__device__ __forceinline__ s16x4 vtr(lds_cptr p){ return __builtin_bit_cast(s16x4,__builtin_amdgcn_ds_read_tr16_b64_v4i16((__attribute__((address_space(3))) v4i16_t*)p)); }
__device__ __forceinline__ float rowmax(const f32x16&p0,const f32x16&p1){
  float a=max3f(p0[0],p0[1],p1[0]),b=max3f(p0[2],p0[3],p1[1]);a=max3f(a,p1[2],p1[3]);
  #pragma unroll
  for(int r=4;r<16;r+=4){a=max3f(a,p0[r],p0[r+1]);b=max3f(b,p0[r+2],p0[r+3]);a=max3f(a,p1[r],p1[r+1]);b=max3f(b,p1[r+2],p1[r+3]);}
  const float m=max2f(a,b);
  auto rr=__builtin_amdgcn_permlane32_swap(__float_as_uint(m),__float_as_uint(m),false,false);
  return max2f(__uint_as_float(rr[0]),__uint_as_float(rr[1]));
}
__device__ __forceinline__ void pv(f32x16*o,int vb,bf16x8 pa0,bf16x8 pa1,bf16x8 pa2,bf16x8 pa3){
  #pragma unroll
  for(int d0=0;d0<2;++d0){s16x4 lo[4],hi[4];
    #pragma unroll
    for(int ks=0;ks<4;++ks){
      asm volatile("ds_read_b64_tr_b16 %0,%1 offset:%c2":"=&v"(lo[ks]):"v"(vb),"i"(d0*4096+ks*1024):"memory");
      asm volatile("ds_read_b64_tr_b16 %0,%1 offset:%c2":"=&v"(hi[ks]):"v"(vb),"i"(d0*4096+ks*1024+512):"memory");}
    asm volatile("s_waitcnt lgkmcnt(0)":::"memory");SBAR();
    #define PK(k) (bf16x8){lo[k][0],lo[k][1],lo[k][2],lo[k][3],hi[k][0],hi[k][1],hi[k][2],hi[k][3]}
    o[d0]=__builtin_amdgcn_mfma_f32_32x32x16_bf16(pa0,PK(0),o[d0],0,0,0);
    o[d0]=__builtin_amdgcn_mfma_f32_32x32x16_bf16(pa1,PK(1),o[d0],0,0,0);
    o[d0]=__builtin_amdgcn_mfma_f32_32x32x16_bf16(pa2,PK(2),o[d0],0,0,0);
    o[d0]=__builtin_amdgcn_mfma_f32_32x32x16_bf16(pa3,PK(3),o[d0],0,0,0);
    #undef PK
  }
}

#ifndef ATTN_STORE16
#define ATTN_STORE16(p,v) (*(u32x4*)(p)=(v))
#endif
struct AU { const bf16* Q; bf16* O; const bf16* K; const bf16* V; int kvp; int NT; int koff; int mode; int q0; float sink_l2; float* scr; float lam; const float* gsub; float sub_scale; };
template<int THRL,bool MASK> __device__ __forceinline__ void attn_unit(const AU&a,char*shm){
  int tid_=threadIdx.x; asm volatile("":"+v"(tid_)); const int tid=tid_,lane=tid&63,r32=lane&31,hi=lane>>5; const int wid=__builtin_amdgcn_readfirstlane(tid>>6);
  const bf16*Qw=a.Q+(long)(wid*QBLK)*QP;
  const bf16*Kh=a.K,*Vh=a.V; const long kvp=a.kvp; const int koff=a.koff;
  const unsigned lds0=(unsigned)(uintptr_t)shm;
  float*wsf=(float*)(shm+LDS_WS)+wid*64;
  const bf16*ksrc=Kh+(long)lane*kvp+wid*8;
  const bf16*vsrc=Vh+(long)(16*(wid&3)+(lane>>2))*kvp+(wid>>2)*32+(lane&3)*8;
  const unsigned kdst=lds0+LDS_K+wid*1024, vdst=lds0+LDS_V+wid*1024;
  #define TROW(t) (KVBLK*(t)+(((t)>=4)?koff:0))
  #define DMA_K(t,slot) glds16(ksrc+(long)TROW(t)*kvp,(unsigned)__builtin_amdgcn_readfirstlane(kdst+(slot)))
  #define DMA_V(t,slot) glds16(vsrc+(long)TROW(t)*kvp,(unsigned)__builtin_amdgcn_readfirstlane(vdst+(slot)))
  const int vb0=(int)(lds0+LDS_V)+((lane>>4)&1)*32+(lane&3)*8+(4*hi+((lane&15)>>2))*64;
  const char*Kbase=shm+LDS_K; bf16x8 kf[8];
  const lds_cptr shm3=(lds_cptr)shm; const lds_cptr kp0=shm3+LDS_K+hi*1024+r32*16; const lds_cptr vp0=shm3+LDS_V+((lane>>4)&1)*32+(lane&3)*8+(4*hi+((lane&15)>>2))*64;
  const int NT=a.NT;
  DMA_K(0,0);DMA_V(0,0);DMA_K(1,SLOTB);
  bf16x8 qr[4];
  #pragma unroll
  for(int d0=0;d0<4;++d0)qr[d0]=*reinterpret_cast<const bf16x8*>(&Qw[(long)r32*QP+d0*16+hi*8]);
  if(a.mode==2){qr[2]=bf16x8{};qr[3]=bf16x8{};} else if(a.mode==3){qr[0]=bf16x8{};qr[1]=bf16x8{};}
  float mhat=0.f,l_reg=0.f;f32x16 o[2];o[0]=f32x16{};o[1]=f32x16{};f32x16 negm=f32x16{};asm volatile("":"+v"(negm));
  const int qpos=a.q0+wid*QBLK+r32;
  #define CMASK(P0,P1,t) do{ if(MASK){ if((t)>=4) bmask(P0,P1,koff+KVBLK*((t)-4)-qpos,hi); } }while(0)
  bool resc=false;
  #define START(P0,P1) do{ const float rm=rowmax(P0,P1); resc=false; \
    { const float dl=rm; mhat=fadd_s(mhat,dl); \
      _Pragma("unroll") for(int r=0;r<16;++r){P0[r]=fsub_s(P0[r],dl);P1[r]=fsub_s(P1[r],dl);} \
      _Pragma("unroll") for(int r=0;r<16;++r)negm[r]=-mhat; asm volatile("":"+v"(negm)); } \
    _Pragma("unroll") for(int r=0;r<16;++r)P0[r]=__builtin_amdgcn_exp2f(P0[r]); }while(0)
  #define RESC() do{ if(resc){ asm volatile("s_waitcnt lgkmcnt(0)":::"memory"); \
      _Pragma("unroll") for(int d_=0;d_<2;++d_) _Pragma("unroll") for(int r=0;r<16;++r)o[d_][r]*=wsf[crow(r,hi)]; } }while(0)
  f32x16 pA0,pA1,pB0,pB1;
  int sl_prev=0,sl_cur=0,sl_next=SLOTB;
  #define ROT() do{sl_prev=sl_cur;sl_cur=sl_next;sl_next=(sl_next==(NSLOT-1)*SLOTB)?0:sl_next+SLOTB;}while(0)
  DMA_K(2,2*SLOTB);
  WAIT_BAR(3);
  qkt(pA0,pA1,Kbase,qr,negm,r32,hi);asm volatile("s_nop 15\n\ts_nop 7":"+v"(pA0),"+v"(pA1));CMASK(pA0,pA1,0);
  START(pA0,pA1);
  _Pragma("unroll") for(int r=0;r<16;++r)pA1[r]=__builtin_amdgcn_exp2f(pA1[r]);
  WAIT_BAR(0);
  DMA_K(3,0);DMA_V(1,SLOTB);
  ROT();
  kload8(kf,kp0+sl_cur);
  WAIT_BAR(2);
  s16x4 vlo[8],vhi[8]; u32x4 pw0,pw1,pw2,pw3;
  #define PKW(P,B) cvtpk_s(P[B],P[B+1])
  #define PAF(k) __builtin_bit_cast(bf16x8,pw##k)
  #define VFR(i) (bf16x8){vlo[i][0],vlo[i][1],vlo[i][2],vlo[i][3],vhi[i][0],vhi[i][1],vhi[i][2],vhi[i][3]}
  #define PIN(x) asm volatile("":"+v"(x))
  #define MX3(a,b,c) __builtin_fmaxf(__builtin_fmaxf((a),(b)),(c))
  #define GAPA(MF,A0,A1,A2,A3,W0,W1,PW) do{ MF; sacc+=A0; sacc+=A1; sacc+=A2; sacc+=A3; PIN(sacc); W0; W1; PIN(PW); SBAR(); }while(0)
  #define EX(v) __builtin_amdgcn_exp2f(v)
  #define GAPB(MF,X,B) do{ MF; X[B]=EX(X[B]); X[B+1]=EX(X[B+1]); X[B+2]=EX(X[B+2]); X[B+3]=EX(X[B+3]); PIN(X); SBAR(); }while(0)
  #define VRD(i) do{ vlo[i]=vtr(vp_+(((i)>>2)*4096+((i)&3)*1024)); vhi[i]=vtr(vp_+(((i)>>2)*4096+((i)&3)*1024+512)); }while(0)
  #define KRD(G,j) do{ if(G){ kload2(kf,kp0+sl_next,j); SBAR(); } }while(0)
  #define STEP(C0,C1,P0,P1,t,GK,GV,GL) do{ SBAR(); \
    const lds_cptr vp_=vp0+sl_prev; \
    VRD(0); SBAR(); float sacc=(P0[0]+P0[1]); \
    GAPA(C0=__builtin_amdgcn_mfma_f32_32x32x16_bf16(kf[0],qr[0],negm,0,0,0), P0[2],P0[3],P0[4],P0[5],     pw0[0]=PKW(P0,0), pw0[1]=PKW(P0,2), pw0); \
    VRD(4); SBAR(); GAPA(C1=__builtin_amdgcn_mfma_f32_32x32x16_bf16(kf[1],qr[0],negm,0,0,0), P0[6],P0[7],P0[8],P0[9],     pw0[2]=PKW(P0,4), pw0[3]=PKW(P0,6), pw0); \
    VRD(1); SBAR(); GAPA(C0=__builtin_amdgcn_mfma_f32_32x32x16_bf16(kf[2],qr[1],C0,0,0,0),   P0[10],P0[11],P0[12],P0[13], pw1[0]=PKW(P0,8), pw1[1]=PKW(P0,10), pw1); \
    VRD(5); SBAR(); GAPA(C1=__builtin_amdgcn_mfma_f32_32x32x16_bf16(kf[3],qr[1],C1,0,0,0),   P0[14],P0[15],P1[0],P1[1],   pw1[2]=PKW(P0,12),pw1[3]=PKW(P0,14), pw1); \
    VRD(2); SBAR(); GAPA(C0=__builtin_amdgcn_mfma_f32_32x32x16_bf16(kf[4],qr[2],C0,0,0,0),   P1[2],P1[3],P1[4],P1[5],     pw2[0]=PKW(P1,0), pw2[1]=PKW(P1,2), pw2); \
    VRD(6); SBAR(); GAPA(C1=__builtin_amdgcn_mfma_f32_32x32x16_bf16(kf[5],qr[2],C1,0,0,0),   P1[6],P1[7],P1[8],P1[9],     pw2[2]=PKW(P1,4), pw2[3]=PKW(P1,6), pw2); \
    VRD(3); SBAR(); GAPA(C0=__builtin_amdgcn_mfma_f32_32x32x16_bf16(kf[6],qr[3],C0,0,0,0),   P1[10],P1[11],P1[12],P1[13], pw3[0]=PKW(P1,8), pw3[1]=PKW(P1,10), pw3); \
    VRD(7); SBAR(); GAPA(C1=__builtin_amdgcn_mfma_f32_32x32x16_bf16(kf[7],qr[3],C1,0,0,0),   P1[14],P1[15],0.f,0.f,       pw3[2]=PKW(P1,12),pw3[3]=PKW(P1,14), pw3); \
    l_reg+=sacc; \
    if(GK){DMA_K((t)+3,sl_cur);} if(GV){DMA_V((t)+1,sl_next);} \
    CMASK(C0,C1,t); \
    { float a=MX3(C0[0],C0[1],C1[0]),b=MX3(C0[2],C0[3],C1[1]); a=MX3(a,C1[2],C1[3]); \
      _Pragma("unroll") for(int r=4;r<16;r+=4){a=MX3(a,C0[r],C0[r+1]);b=MX3(b,C0[r+2],C0[r+3]);a=MX3(a,C1[r],C1[r+1]);b=MX3(b,C1[r+2],C1[r+3]);} \
      float rm=__builtin_fmaxf(a,b); { auto rr=__builtin_amdgcn_permlane32_swap(__float_as_uint(rm),__float_as_uint(rm),false,false); rm=__builtin_fmaxf(__uint_as_float(rr[0]),__uint_as_float(rr[1])); } \
      resc=false; \
      if(__builtin_expect(__any(rm>(float)THRL),0)){ const float dl=__builtin_fmaxf(rm,0.f); mhat+=dl; \
        _Pragma("unroll") for(int r=0;r<16;++r){C0[r]-=dl;C1[r]-=dl;} \
        _Pragma("unroll") for(int r=0;r<16;++r)negm[r]=-mhat; asm volatile("":"+v"(negm)); \
        const float f=__builtin_amdgcn_exp2f(-dl); l_reg*=f; if(hi==0)wsf[r32]=f; resc=true; } } \
    SBAR(); \
    GAPB(o[0]=__builtin_amdgcn_mfma_f32_32x32x16_bf16(PAF(0),VFR(0),o[0],0,0,0), C0,0); \
    GAPB(o[1]=__builtin_amdgcn_mfma_f32_32x32x16_bf16(PAF(0),VFR(4),o[1],0,0,0), C0,4); \
    KRD(GL,0); GAPB(o[0]=__builtin_amdgcn_mfma_f32_32x32x16_bf16(PAF(1),VFR(1),o[0],0,0,0), C0,8); \
    KRD(GL,1); GAPB(o[1]=__builtin_amdgcn_mfma_f32_32x32x16_bf16(PAF(1),VFR(5),o[1],0,0,0), C0,12); \
    KRD(GL,2); GAPB(o[0]=__builtin_amdgcn_mfma_f32_32x32x16_bf16(PAF(2),VFR(2),o[0],0,0,0), C1,0); \
    KRD(GL,3); GAPB(o[1]=__builtin_amdgcn_mfma_f32_32x32x16_bf16(PAF(2),VFR(6),o[1],0,0,0), C1,4); \
    GAPB(o[0]=__builtin_amdgcn_mfma_f32_32x32x16_bf16(PAF(3),VFR(3),o[0],0,0,0), C1,8); \
    GAPB(o[1]=__builtin_amdgcn_mfma_f32_32x32x16_bf16(PAF(3),VFR(7),o[1],0,0,0), C1,12); \
    }while(0)
  int t=1;
  for(;t+5<NT;t+=2){
    STEP(pB0,pB1,pA0,pA1,t,true,true,true);     WAIT_BAR(2); RESC(); ROT();
    STEP(pA0,pA1,pB0,pB1,t+1,true,true,true);   WAIT_BAR(2); RESC(); ROT();
  }
  #define ENDW(tt) do{ if((tt)+3<NT){WAIT_BAR(2);} else if((tt)+2<NT){WAIT_BAR(1);} else {WAIT_BAR(0);} }while(0)
  for(;t+1<NT;t+=2){
    STEP(pB0,pB1,pA0,pA1,t,(t+3<NT),(t+1<NT),(t+1<NT));       ENDW(t);   RESC(); ROT();
    STEP(pA0,pA1,pB0,pB1,t+1,(t+4<NT),(t+2<NT),(t+2<NT));     ENDW(t+1); RESC(); ROT();
  }
  STEP(pB0,pB1,pA0,pA1,NT-1,false,false,false); RESC();
  { float sacc=pB0[0]+pB0[1]; _Pragma("unroll") for(int r=2;r<16;++r)sacc+=pB0[r]; _Pragma("unroll") for(int r=0;r<16;++r)sacc+=pB1[r]; l_reg+=sacc;
    pw0=(u32x4){PKW(pB0,0),PKW(pB0,2),PKW(pB0,4),PKW(pB0,6)};pw1=(u32x4){PKW(pB0,8),PKW(pB0,10),PKW(pB0,12),PKW(pB0,14)};pw2=(u32x4){PKW(pB1,0),PKW(pB1,2),PKW(pB1,4),PKW(pB1,6)};pw3=(u32x4){PKW(pB1,8),PKW(pB1,10),PKW(pB1,12),PKW(pB1,14)};
    SBAR(); pv(o,vb0+sl_cur,PAF(0),PAF(1),PAF(2),PAF(3)); }
  #undef PKW
  #undef PAF
  #undef VFR
  #undef PIN
  #undef MX3
  #undef GAPA
  #undef GAPB
  #undef EX
  #undef VRD
  #undef KRD
  #undef STEP
  #undef ENDW
  {auto rr=__builtin_amdgcn_permlane32_swap(__float_as_uint(l_reg),__float_as_uint(l_reg),false,false);l_reg=__uint_as_float(rr[0])+__uint_as_float(rr[1]);}
  if(a.mode==1)l_reg+=__builtin_amdgcn_exp2f(a.sink_l2-mhat);
  if(hi==0)wsf[32+r32]=l_reg;asm volatile("s_waitcnt lgkmcnt(0)":::"memory");
  float rli[16];
  #pragma unroll
  for(int r=0;r<16;++r)rli[r]=__builtin_amdgcn_rcpf(wsf[32+crow(r,hi)]);
  bf16*Ow=a.O+(long)(wid*QBLK)*QP;
  if(a.mode==2){
    float*sc=a.scr+(long)wid*2048+lane;
    #pragma unroll
    for(int r=0;r<16;++r){
      #pragma unroll
      for(int d0=0;d0<2;++d0)sc[(2*r+d0)*64]=o[d0][r]*rli[r];}
  } else if(a.mode==3){
    const float*sc=a.scr+(long)wid*2048+lane; float*stf=(float*)(shm+LDS_OST)+wid*2048; float*pst=stf+hi*256+r32;
    #pragma unroll
    for(int r=0;r<16;++r){
      #pragma unroll
      for(int d0=0;d0<2;++d0)pst[((r&3)+8*(r>>2))*64+d0*32]=sc[(2*r+d0)*64]-a.lam*(o[d0][r]*rli[r]);}
    asm volatile("s_waitcnt lgkmcnt(0)":::"memory");
    const int c4=lane&15; const f32x4 gs4=*(const f32x4*)(a.gsub+4*c4); const float*prd=stf+(lane>>4)*64+4*c4; bf16*pwr=Ow+(long)(lane>>4)*QP+4*c4;
    #pragma unroll
    for(int i=0;i<8;++i){f32x4 v=*(const f32x4*)(prd+i*256);
      float ss=(v[0]*v[0]+v[1]*v[1])+(v[2]*v[2]+v[3]*v[3]); ss+=__shfl_xor(ss,1); ss+=__shfl_xor(ss,2); ss+=__shfl_xor(ss,4); ss+=__shfl_xor(ss,8);
      const float rn=rsqrtf(ss*(1.0f/64.0f)+1e-6f)*a.sub_scale; v=v*rn*gs4;
      u32x2 pk; pk.x=cvtpk_s(v[0],v[1]); pk.y=cvtpk_s(v[2],v[3]); *(u32x2*)(pwr+(long)i*4*QP)=pk;}
  } else
  { bf16*stg=(bf16*)(shm+LDS_OST)+wid*2048;
    #pragma unroll
    for(int r=0;r<16;++r){const int orow=crow(r,hi);
      #pragma unroll
      for(int d0=0;d0<2;++d0)stg[orow*64+d0*32+r32]=__float2bfloat16(o[d0][r]*rli[r]);}
    asm volatile("s_waitcnt lgkmcnt(0)":::"memory");
    #pragma unroll
    for(int i=0;i<4;++i){const int row=i*8+(lane>>3),ch=lane&7; const u32x4 v=*(const u32x4*)(stg+row*64+ch*8); ATTN_STORE16(Ow+(long)row*QP+ch*8,v);} }
  asm volatile("s_waitcnt lgkmcnt(0)\n\ts_barrier":::"memory");
  #undef DMA_K
  #undef DMA_V
  #undef CMASK
  #undef START
  #undef RESC
  #undef TROW
  #undef ROT
}
constexpr int ATTN_LDS_BYTES=LDS_BYTES;
#undef SBAR
#undef WAIT_BAR
}

constexpr int NWAVES = 8;
#ifndef MK_N_LAUNCHES
#define MK_N_LAUNCHES 1
#endif
constexpr int DEPTH = 2, DMODEL = 1024, DIN = 2048, DUP = 5632, DFF = 2816, NTOK = 12288, NPROMPT = 4096;
constexpr int N_PHASES = 2 + 5 * DEPTH + 1;
constexpr size_t MiB = 1u << 20;
constexpr size_t WS_CTL = 0, CTL_ZERO_BYTES = 1 * MiB;
constexpr int CW_TMO = 0, CW_CODE = 1, CW_BAR = 4096, CW_QUEUE = 8192;
constexpr size_t CTL_SUMSQ = 64 * 1024;
constexpr size_t CTL_MOD = 256 * 1024;
constexpr size_t CTL_CIN = 400 * 1024;
constexpr size_t CTL_CUP = 448 * 1024;
static_assert(CTL_CUP + (size_t)DEPTH * 3 * DUP * 4 <= CTL_ZERO_BYTES && CTL_SUMSQ + 4 * (size_t)NTOK * 4 <= CTL_MOD && CTL_MOD + (size_t)DEPTH * 3 * 6144 * 4 <= CTL_CIN && CTL_CIN + (size_t)DEPTH * 3 * DIN * 4 <= CTL_CUP, "ctl map");
constexpr size_t WS_SS0 = 1 * MiB;
constexpr size_t WS_ROPE = WS_SS0 + 64 * 1024;
constexpr size_t WS_LAM = WS_ROPE + 16 * 1024;
constexpr size_t WS_W = 2 * MiB;
constexpr size_t W_IN_OFF = 0, W_OUT_OFF = 4 * MiB, W_UP_OFF = 6 * MiB, W_DOWN_OFF = 17 * MiB, W_LAYER = 22 * MiB + MiB / 2;
constexpr size_t WS_H1 = 48 * MiB;
constexpr size_t WS_QO = 72 * MiB;
constexpr size_t WS_KV = 96 * MiB;
constexpr size_t WS_H2 = 122 * MiB;
constexpr size_t WS_SCR = 146 * MiB;
constexpr size_t WS_ACT = 158 * MiB;
constexpr size_t WS_HALO = 224 * MiB;
constexpr size_t WS_END = 233 * MiB;
static_assert(WS_W + DEPTH * W_LAYER <= WS_H1 && WS_KV + (size_t)pg8::KV_ELEMS * 2 <= WS_H2 && WS_SCR + (size_t)4 * NTOK * 64 * 4 <= WS_ACT && WS_ACT + (size_t)NTOK * DFF * 2 <= WS_HALO && WS_HALO + (size_t)96 * 4 * DUP * 4 <= WS_END, "ws map");
constexpr int RING_OFF = 0, RING_BYTES = 131072;
constexpr int LDSCTL_OFF = RING_BYTES, MISC_OFF = LDSCTL_OFF + 320;
constexpr int LDS_BYTES = 147456;
static_assert(attn_body::ATTN_LDS_BYTES <= RING_BYTES, "attention scratch fits the ring region");

#define GAS __attribute__((address_space(1)))
#define LAS __attribute__((address_space(3)))
typedef unsigned short bf16;
typedef unsigned v4u __attribute__((ext_vector_type(4)));
typedef float f32x4 __attribute__((ext_vector_type(4)));
typedef short bf16x8 __attribute__((ext_vector_type(8)));
typedef GAS unsigned gu32;
typedef GAS unsigned long long gu64;
#define RLX_AGENT __ATOMIC_RELAXED, __HIP_MEMORY_SCOPE_AGENT
#define LDS_WAIT() asm volatile("s_waitcnt lgkmcnt(0)" ::: "memory")
#define VM_WAIT() asm volatile("s_waitcnt vmcnt(0)" ::: "memory")
__device__ __forceinline__ unsigned long long rt() { return __builtin_amdgcn_s_memrealtime(); }
__device__ __forceinline__ unsigned f2bf(float f) { unsigned u = __builtin_bit_cast(unsigned, f); return (u + 0x7fffu + ((u >> 16) & 1u)) >> 16; }
__device__ __forceinline__ unsigned pk2(float lo, float hi) { return f2bf(lo) | (f2bf(hi) << 16); }

#define XB_TMO      128
#define XB_XCNT(j)  (256  + 64 * (j))
#define XB_XSUB(j)  (1280 + 64 * (j))
#define XB_XGEN(j)  (2304 + 64 * (j))
#define XB_TOP      3328
#define XB_TOPGEN   3392
#define XCD_BAR_WORDS 3456
#define XB_SPIN_CAP (1u << 18)

__device__ __forceinline__ unsigned xb_ld(unsigned* p)              { return __hip_atomic_load(p, __ATOMIC_RELAXED, __HIP_MEMORY_SCOPE_AGENT); }
__device__ __forceinline__ unsigned xb_add(unsigned* p, unsigned v) { return __hip_atomic_fetch_add(p, v, __ATOMIC_RELAXED, __HIP_MEMORY_SCOPE_AGENT); }
__device__ __forceinline__ unsigned xb_xcc_id() { return (unsigned)__builtin_amdgcn_s_getreg((3 << 11) | 20) & 0xFu; }
#define XB_SPIN(cond, bar) do { unsigned _sp = 0; while (cond) { __builtin_amdgcn_s_sleep(1); \
    if ((++_sp & 255u) == 0u) { if (xb_ld(&(bar)[XB_TMO])) break; if (_sp > XB_SPIN_CAP) { atomicAdd(&(bar)[XB_TMO], 1u); break; } } } } while (0)

struct XcdBarrier {
    unsigned* bar; unsigned x;
    volatile LAS unsigned* st;
};

__device__ __forceinline__ XcdBarrier xcd_barrier_post(unsigned* bar, volatile LAS unsigned* st) {
    XcdBarrier b; b.bar = bar; b.x = xb_xcc_id(); b.st = st;
    if (threadIdx.x == 0) (void)xb_add(&bar[XB_XCNT(b.x)], 1u);
    return b;
}
__device__ __forceinline__ void xcd_barrier_complete(unsigned* bar, unsigned x, unsigned& nloc, unsigned& nx) {
    const unsigned G = gridDim.x * gridDim.y * gridDim.z;
    unsigned sum, cnt, mine, sp = 0u;
    for (;;) {
        sum = 0u; cnt = 0u; mine = 0u;
#pragma unroll
        for (unsigned j = 0; j < 16; ++j) { const unsigned c = xb_ld(&bar[XB_XCNT(j)]); sum += c; cnt += (c > 0u) ? 1u : 0u; mine = (j == x) ? c : mine; }
        if (sum == G) break;
        __builtin_amdgcn_s_sleep(1);
        if ((++sp & 255u) == 0u) { if (xb_ld(&bar[XB_TMO])) break; if (sp > XB_SPIN_CAP) { atomicAdd(&bar[XB_TMO], 1u); break; } }
    }
    nloc = mine > 0u ? mine : 1u; nx = cnt > 0u ? cnt : 1u;
}

__device__ __forceinline__ void xcd_barrier(const XcdBarrier& b) {
    asm volatile("s_waitcnt vmcnt(0)" ::: "memory");
    __syncthreads();
    if (threadIdx.x == 0) {
        unsigned* bar = b.bar;
        __builtin_amdgcn_s_waitcnt(0);
        unsigned nloc = b.st[0], nx = b.st[1];
        if (nloc == 0u) { xcd_barrier_complete(bar, b.x, nloc, nx); b.st[0] = nloc; b.st[1] = nx; }
        const unsigned old = xb_add(&bar[XB_XSUB(b.x)], 1u);
        const unsigned gen = old / nloc;
        if (old + 1u == (gen + 1u) * nloc) {
            __builtin_amdgcn_fence(__ATOMIC_RELEASE, "agent");
            asm volatile("s_waitcnt vmcnt(0)" ::: "memory");
            const unsigned og = xb_add(&bar[XB_TOP], 1u);
            const unsigned tg = og / nx;
            if (og + 1u == (tg + 1u) * nx) xb_add(&bar[XB_TOPGEN], 1u);
            else XB_SPIN(xb_ld(&bar[XB_TOPGEN]) == tg, bar);
            __builtin_amdgcn_fence(__ATOMIC_ACQUIRE, "agent");
            xb_add(&bar[XB_XGEN(b.x)], 1u);
            asm volatile("s_waitcnt vmcnt(0)" ::: "memory");
        } else {
            XB_SPIN(xb_ld(&bar[XB_XGEN(b.x)]) == gen, bar);
            __builtin_amdgcn_fence(__ATOMIC_ACQUIRE, "agent");
            asm volatile("s_waitcnt vmcnt(0)" ::: "memory");
        }
    }
    __syncthreads();
}


struct Frame {
    LAS unsigned char* lds; volatile LAS unsigned* MISC; gu32* ctl;
    int tid, lane, wave, vcu, G;
    const float* const* in; float* out; unsigned char* ws;
};
__device__ __forceinline__ float wave_sum(float v) {
#pragma unroll
    for (int o = 1; o < 64; o <<= 1) v += __shfl_xor(v, o);
    return v;
}
template <class T> __device__ __forceinline__ T* uni(T* p) {
    const unsigned long long v = (unsigned long long)p; const unsigned lo = __builtin_amdgcn_readfirstlane((unsigned)v), hi = __builtin_amdgcn_readfirstlane((unsigned)(v >> 32));
    return (T*)(GAS T*)(((unsigned long long)hi << 32) | lo);
}
__device__ __forceinline__ float silu_f(float x) { return x / (1.0f + __expf(-x)); }

__device__ __forceinline__ int phys_in(int L) {
    const int g = L >> 6, d = L & 63, pn = g >> 2, wc = g & 3, bj = d >> 5; int n, fq, j;
    if (g >= 20 && g < 28) { const int x = d & 31, p = x >> 4, i = x & 7; n = (x >> 3) & 1; fq = 2 * p + (i >> 2); j = i & 3; }
    else { n = (d >> 4) & 1; fq = (d >> 2) & 3; j = d & 3; }
    return 256 * pn + 128 * bj + 32 * wc + 16 * n + 4 * fq + j;
}
__device__ __forceinline__ int phys_up(int L) {
    const int bj = L >= 2816 ? 1 : 0, c = L - 2816 * bj, pn = c >> 7, y = c & 127, wc = y >> 5, z = y & 31, fq = z >> 3, n = (z >> 2) & 1, j = z & 3;
    return 256 * pn + 128 * bj + 32 * wc + 16 * n + 4 * fq + j;
}
template <int PM> __device__ __forceinline__ void transpose_item(const float* W, int K, int N, bf16* WT, LAS float* scr, int item, int lane, const float* shp, float* cdst) {
    const int nblk = N / 32, kb = item / nblk, nb = item % nblk, k0 = 64 * kb, n0 = 32 * nb;
#pragma unroll 8
    for (int i = 0; i < 32; ++i) { const int kk = 2 * i + (lane >> 5); scr[kk * 33 + (lane & 31)] = W[(size_t)(k0 + kk) * N + n0 + (lane & 31)]; }
    LDS_WAIT(); asm volatile("" ::: "memory");
    const int c = lane & 7;
#pragma unroll
    for (int j = 0; j < 4; ++j) { const int n = (lane >> 3) + 8 * j; const LAS float* s = scr + (8 * c) * 33 + n;
        v4u o; o.x = pk2(s[0 * 33], s[1 * 33]); o.y = pk2(s[2 * 33], s[3 * 33]); o.z = pk2(s[4 * 33], s[5 * 33]); o.w = pk2(s[6 * 33], s[7 * 33]);
        const int L = n0 + n, row = (PM == 1) ? phys_in(L) : (PM == 2) ? phys_up(L) : L;
        *(GAS v4u*)(WT + (size_t)row * K + k0 + 8 * c) = o; }
    if (shp) {
        const int n = lane & 31, kh = lane >> 5; float a0 = 0.f, a1 = 0.f, a2 = 0.f;
#pragma unroll 8
        for (int kk = 0; kk < 32; ++kk) { const float w = scr[(32 * kh + kk) * 33 + n]; const int k = k0 + 32 * kh + kk; a0 += shp[k] * w; a1 += shp[6144 + k] * w; a2 += shp[2 * 6144 + k] * w; }
        a0 += __shfl_xor(a0, 32); a1 += __shfl_xor(a1, 32); a2 += __shfl_xor(a2, 32);
        if (lane < 32) { unsafeAtomicAdd(cdst + n0 + n, a0); unsafeAtomicAdd(cdst + N + n0 + n, a1); unsafeAtomicAdd(cdst + 2 * N + n0 + n, a2); }
    }
    LDS_WAIT(); asm volatile("" ::: "memory");
}

__device__ __forceinline__ void relane(Frame& F) { int t = threadIdx.x; asm volatile("" : "+v"(t)); F.tid = t; F.lane = t & 63; F.wave = __builtin_amdgcn_readfirstlane(t >> 6); }
__device__ __forceinline__ void p0a(Frame& F) {
    relane(F);
    LAS float* sil = (LAS float*)(F.lds + RING_OFF);
    for (int i = F.tid; i < 3 * DMODEL; i += NWAVES * 64) { const int c = i >> 10, k = i & 1023; const float x = (c == 0) ? F.in[9][k] : F.in[8][(c - 1) * DMODEL + k]; sil[i] = silu_f(x); }
    __syncthreads();
    const int gw = F.vcu * NWAVES + F.wave, NGW = F.G * NWAVES;
    float* mod = (float*)(F.ws + WS_CTL + CTL_MOD);
    for (int it = gw; it < DEPTH * 24 * 32; it += NGW) {
        const int l = it / 768, r = it % 768, cb = r >> 5, kc = r & 31, col = cb * 256 + F.lane * 4;
        const float* wp = F.in[10] + ((size_t)l * DMODEL + kc * 32) * 6144 + col;
        f32x4 a0 = {0.f, 0.f, 0.f, 0.f}, a1 = a0, a2 = a0;
#pragma unroll 8
        for (int kk = 0; kk < 32; ++kk) { const f32x4 w = *(const f32x4*)(wp + (size_t)kk * 6144); const int k = kc * 32 + kk; a0 += w * sil[k]; a1 += w * sil[1024 + k]; a2 += w * sil[2048 + k]; }
        if (kc == 0) { const f32x4 b = *(const f32x4*)(F.in[11] + l * 6144 + col); a0 += b; a1 += b; a2 += b; }
        float* mp = mod + (size_t)l * 3 * 6144 + col;
#pragma unroll
        for (int j = 0; j < 4; ++j) { unsafeAtomicAdd(mp + j, a0[j]); unsafeAtomicAdd(mp + 6144 + j, a1[j]); unsafeAtomicAdd(mp + 2 * 6144 + j, a2[j]); }
    }
    __syncthreads();
    LAS float* scr = (LAS float*)(F.lds + RING_OFF + F.wave * 16384);
    constexpr int I_O = (DMODEL / 64) * (DMODEL / 32), I_D = (DFF / 64) * (DMODEL / 32);
    for (int it = gw; it < DEPTH * (I_O + I_D); it += NGW) {
        const int l = it / (I_O + I_D); int r = it % (I_O + I_D);
        bf16* wl = (bf16*)(F.ws + WS_W + l * W_LAYER);
        if (r < I_O) transpose_item<0>(F.in[23] + (size_t)l * DMODEL * DMODEL, DMODEL, DMODEL, (bf16*)((unsigned char*)wl + W_OUT_OFF), scr, r, F.lane, nullptr, nullptr);
        else transpose_item<0>(F.in[27] + (size_t)l * DFF * DMODEL, DFF, DMODEL, (bf16*)((unsigned char*)wl + W_DOWN_OFF), scr, r - I_O, F.lane, nullptr, nullptr);
    }
    const int gt = F.vcu * NWAVES * 64 + F.tid;
    float* rope = (float*)(F.ws + WS_ROPE);
    if (gt < 1024) { const int pos = gt >> 4, i = gt & 15; const double ang = (double)pos * pow(10000.0, -(double)i / 16.0); rope[gt] = (float)cos(ang); rope[1024 + gt] = (float)sin(ang); }
    else if (gt < 1536) { const int q = gt - 1024, pos = q >> 3, i = q & 7; const double ang = (double)pos * pow(10000.0, -(double)i / 8.0); rope[2048 + q] = (float)cos(ang); rope[2560 + q] = (float)sin(ang); }
    else if (gt < 1536 + DEPTH) { const int l = gt - 1536; float s1 = 0.f, s2 = 0.f;
        for (int i = 0; i < 32; ++i) { s1 += F.in[18][l * 32 + i] * F.in[19][l * 32 + i]; s2 += F.in[20][l * 32 + i] * F.in[21][l * 32 + i]; }
        const float lam_init = 0.8f - 0.6f * expf(-0.3f * (float)l);
        ((float*)(F.ws + WS_LAM))[l] = expf(s1) - expf(s2) + lam_init; }
}
__device__ __forceinline__ void p0b(Frame& F) {
    relane(F);
    LAS float* scr = (LAS float*)(F.lds + RING_OFF + F.wave * 16384);
    const int gw = F.vcu * NWAVES + F.wave, NGW = F.G * NWAVES;
    const float* mod = (const float*)(F.ws + WS_CTL + CTL_MOD);
    constexpr int I_I = (DMODEL / 64) * (DIN / 32), I_U = (DMODEL / 64) * (DUP / 32);
    for (int it = gw; it < DEPTH * (I_I + I_U); it += NGW) {
        const int l = it / (I_I + I_U); int r = it % (I_I + I_U);
        unsigned char* wl = F.ws + WS_W + l * W_LAYER; const float* ml = mod + (size_t)l * 3 * 6144;
        if (r < I_I) transpose_item<1>(F.in[14] + (size_t)l * DMODEL * DIN, DMODEL, DIN, (bf16*)(wl + W_IN_OFF), scr, r, F.lane, ml + 0, (float*)(F.ws + WS_CTL + CTL_CIN) + (size_t)l * 3 * DIN);
        else transpose_item<2>(F.in[24] + (size_t)l * DMODEL * DUP, DMODEL, DUP, (bf16*)(wl + W_UP_OFF), scr, r - I_I, F.lane, ml + 3072, (float*)(F.ws + WS_CTL + CTL_CUP) + (size_t)l * 3 * DUP);
    }
    bf16* H1 = (bf16*)(F.ws + WS_H1); float* ss0 = (float*)(F.ws + WS_SS0);
    for (int m = gw; m < NTOK; m += NGW) {
        const float* xr = (m < NPROMPT) ? F.in[0] + (size_t)m * DMODEL : F.in[1] + (size_t)(m - NPROMPT) * DMODEL;
        const int cond = (m < NPROMPT) ? 0 : 1 + ((m - NPROMPT) >> 12);
        const float* sc = mod + (size_t)cond * 6144 + 1024; const float* g1 = F.in[12];
        float s = 0.f; GAS unsigned long long* o8 = (GAS unsigned long long*)(H1 + (size_t)m * DMODEL) + F.lane;
#pragma unroll
        for (int j = 0; j < 4; ++j) { const int k = 4 * F.lane + 256 * j; const f32x4 v = *(const f32x4*)(xr + k); s += (v.x * v.x + v.y * v.y) + (v.z * v.z + v.w * v.w);
            const f32x4 w = v * (*(const f32x4*)(g1 + k)) * (*(const f32x4*)(sc + k) + 1.0f);
            o8[64 * j] = (unsigned long long)pk2(w.x, w.y) | ((unsigned long long)pk2(w.z, w.w) << 32); }
        s = wave_sum(s); if (F.lane == 0) ss0[m] = s;
    }
}
__device__ __forceinline__ void cache_rows(Frame& F, int l) {
    relane(F);
    bf16* KV = (bf16*)(F.ws + WS_KV);
    const int gt = F.vcu * NWAVES * 64 + F.tid, NT_ = F.G * NWAVES * 64;
    for (int i = gt; i < 131072; i += NT_) {
        int which, q; if (i < 65536) { which = i >> 14; q = i & 16383; } else { which = 4 + ((i - 65536) >> 15); q = (i - 65536) & 32767; }
        const int pitch = which < 4 ? 128 : 256, per = 256 * pitch / 4;
        const int s = q / per, e = (q % per) * 4, p = e / pitch, c = e % pitch;
        const f32x4 v = *(const f32x4*)(F.in[2 + which] + ((size_t)(s * DEPTH + l) * 256 + p) * pitch + c);
        const long off = which == 0 ? pg8::KA_S : which == 1 ? pg8::VA_S : which == 2 ? pg8::KB_S : which == 3 ? pg8::VB_S : which == 4 ? pg8::KC_S : pg8::VC_S;
        *(GAS unsigned long long*)(KV + off + ((size_t)s * 4352 + p) * pitch + c) = (unsigned long long)pk2(v.x, v.y) | ((unsigned long long)pk2(v.z, v.w) << 32);
    }
}
constexpr int N_ATTN_UNITS = 768;
__device__ __forceinline__ void attn_phase(Frame& F, int l) {
    relane(F);
    bf16* QO = (bf16*)(F.ws + WS_QO); const bf16* KV = (const bf16*)(F.ws + WS_KV);
    float* scrb = (float*)(F.ws + WS_SCR);
    const float lam = ((const float*)(F.ws + WS_LAM))[l]; const float lam_init = 0.8f - 0.6f * expf(-0.3f * (float)l);
    const float* sink = F.in[17] + l * 6; const float* gsub = F.in[22] + l * 64;
    gu32* qc = F.ctl + CW_QUEUE + 64 * l;
    char* shm = (char*)F.lds + RING_OFF;
    for (;;) {
        if (F.tid == 0) F.MISC[16] = __hip_atomic_fetch_add(qc, 1u, RLX_AGENT);
        __syncthreads();
        const int idx = __builtin_amdgcn_readfirstlane((int)F.MISC[16]);
        if (idx >= N_ATTN_UNITS) break;
        attn_body::AU a; a.scr = nullptr; a.lam = lam; a.gsub = gsub; a.sub_scale = 1.0f - lam_init; a.sink_l2 = 0.f; a.koff = 0; a.q0 = 0;
        int mix, smp, s, h, qb;
        if (idx < 128) { mix = 2; smp = 1; s = idx >> 6; h = (idx >> 4) & 3; qb = idx & 15; }
        else if (idx < 320) { const int j = idx - 128; mix = 0; smp = 1; s = j / 96; h = (j % 96) >> 4; qb = j & 15; }
        else if (idx < 512) { const int j = idx - 320; mix = 1; smp = 1; s = j / 96; h = (j % 96) >> 4; qb = j & 15; }
        else if (idx < 576) { const int j = idx - 512; mix = 2; smp = 0; s = j >> 2; h = j & 3; qb = 0; }
        else if (idx < 672) { const int j = idx - 576; mix = 0; smp = 0; s = j / 6; h = j % 6; qb = 0; }
        else { const int j = idx - 672; mix = 1; smp = 0; s = j / 6; h = j % 6; qb = 0; }
        const long row0 = smp ? NPROMPT + (long)s * 4096 + qb * 256 : (long)s * 256;
        const int kvh = (mix == 2) ? h : h / 3; const int pitch = (mix == 2) ? 256 : 128;
        const long koffs = smp ? (mix == 0 ? pg8::KA_S : mix == 1 ? pg8::KB_S : pg8::KC_S) : (mix == 0 ? pg8::KA_P : mix == 1 ? pg8::KB_P : pg8::KC_P);
        const long voffs = smp ? (mix == 0 ? pg8::VA_S : mix == 1 ? pg8::VB_S : pg8::VC_S) : (mix == 0 ? pg8::VA_P : mix == 1 ? pg8::VB_P : pg8::VC_P);
        const long seqrow = smp ? (long)s * 4352 : (long)s * 256;
        a.Q = (const attn_body::bf16*)(QO + row0 * 1024 + (mix == 0 ? 0 : mix == 1 ? 384 : 768) + h * 64); a.O = (attn_body::bf16*)a.Q;
        a.K = (const attn_body::bf16*)(KV + koffs + seqrow * pitch + kvh * 64); a.V = (const attn_body::bf16*)(KV + voffs + seqrow * pitch + kvh * 64); a.kvp = pitch;
        a.NT = smp ? 68 : 4; a.q0 = qb * 256;
        int npass = 1;
        if (mix == 2) { a.scr = scrb + ((size_t)h * NTOK + row0) * 64; a.mode = 2; npass = 2; }
        else { a.mode = (mix == 1) ? 1 : 0; if (mix == 1) a.sink_l2 = sink[h] * pg8::LOG2E; }
        if (mix == 1 && smp) {
            const int q0 = qb * 256, ks = (q0 - 128 > 0) ? q0 - 128 : 0, ke = (q0 + 384 < 4096) ? q0 + 384 : 4096;
            a.koff = ks; a.NT = 4 + (ke - ks) / 64;
            attn_body::attn_unit<8, true>(a, shm);
        } else {
#pragma unroll 1
            for (int ps = 0; ps < npass; ++ps) { attn_body::attn_unit<8, false>(a, shm); a.mode = 3; }
        }
    }
}
__device__ __forceinline__ void conv_fixup(Frame& F, int l, int pm) {
    const float* halo = (const float*)(F.ws + WS_HALO); bf16* ACT = (bf16*)(F.ws + WS_ACT);
    const float* cw = F.in[25] + (size_t)l * 3 * DUP; const float* cb = F.in[26] + (size_t)l * DUP;
    for (int it = F.tid; it < 4 * 704; it += NWAVES * 64) {
        const int q = it / 704, c = (it % 704) * 4, s = 2 * pm + (q >> 1), last = q & 1;
        const bool seq_first = (s < 32) ? ((s & 1) == 0) : (((s - 32) & 31) == 0), seq_last = (s < 32) ? ((s & 1) == 1) : (((s - 32) & 31) == 31);
        const float* hs = halo + (size_t)s * 4 * DUP;
        const float* rp; const float* rc; const float* rn; float fp = 1.f, fn = 1.f;
        if (!last) { rc = hs; rn = hs + DUP; rp = hs - DUP; if (seq_first) { fp = 0.f; rp = hs; } }
        else { rp = hs + 2 * DUP; rc = hs + 3 * DUP; rn = hs + 4 * DUP; if (seq_last) { fn = 0.f; rn = hs; } }
        const f32x4 ap = *(const f32x4*)(rp + c) * fp, ac = *(const f32x4*)(rc + c), an = *(const f32x4*)(rn + c) * fn;
        const f32x4 gp = *(const f32x4*)(rp + DFF + c) * fp, gc = *(const f32x4*)(rc + DFF + c), gn = *(const f32x4*)(rn + DFF + c) * fn;
        const f32x4 av = *(const f32x4*)(cw + c) * ap + *(const f32x4*)(cw + DUP + c) * ac + *(const f32x4*)(cw + 2 * DUP + c) * an + *(const f32x4*)(cb + c);
        const f32x4 gv = *(const f32x4*)(cw + DFF + c) * gp + *(const f32x4*)(cw + DUP + DFF + c) * gc + *(const f32x4*)(cw + 2 * DUP + DFF + c) * gn + *(const f32x4*)(cb + DFF + c);
        const size_t row = (size_t)s * 128 + (last ? 127 : 0);
        *(GAS unsigned long long*)(ACT + row * DFF + c) = (unsigned long long)pk2(silu_f(av.x) * gv.x, silu_f(av.y) * gv.y) | ((unsigned long long)pk2(silu_f(av.z) * gv.z, silu_f(av.w) * gv.w) << 32);
    }
}
__device__ __forceinline__ void final_phase(Frame& F) {
    relane(F);
    const float* ssq = (const float*)(F.ws + WS_CTL + CTL_SUMSQ) + 3 * (size_t)NTOK; const float* gf = F.in[28];
    const int gt = F.vcu * NWAVES * 64 + F.tid, NT_ = F.G * NWAVES * 64;
    for (int i = gt; i < NTOK * 256; i += NT_) { const int row = i >> 8, c = (i & 255) * 4;
        const float rstd = rsqrtf(ssq[row] * (1.0f / 1024.0f) + 1e-6f);
        f32x4* p = (f32x4*)(F.out + (size_t)row * DMODEL + c); *p = *p * rstd * (*(const f32x4*)(gf + c)); }
}

struct Args { const float* in[29]; float* out; unsigned char* ws; int ph_lo, ph_hi; };
__global__ void __launch_bounds__(NWAVES * 64, 2) fwd_kernel(const Args args) {
    extern __shared__ __attribute__((aligned(16))) unsigned char lds[];
    Frame F;
    F.lds = (LAS unsigned char*)lds; F.MISC = (volatile LAS unsigned*)(F.lds + MISC_OFF);
    F.tid = threadIdx.x; F.lane = F.tid & 63; F.wave = __builtin_amdgcn_readfirstlane(F.tid >> 6);
    F.G = gridDim.x; { const int bx = blockIdx.x; F.vcu = (F.G % 8 == 0) ? (bx % 8) * (F.G / 8) + bx / 8 : bx; }
    F.in = args.in;
    F.out = args.out; F.ws = args.ws; F.ctl = (gu32*)(args.ws + WS_CTL);
    for (int u = F.tid; u < (LDS_BYTES - LDSCTL_OFF) / 4; u += NWAVES * 64) ((LAS unsigned*)(F.lds + LDSCTL_OFF))[u] = 0u;
    __syncthreads();
    const int lo = args.ph_lo, hi = args.ph_hi;
    XcdBarrier bar; bar.bar = (unsigned*)(F.ctl + CW_BAR); bar.x = 0; bar.st = nullptr;
    if (hi - lo > 1) bar = xcd_barrier_post((unsigned*)(F.ctl + CW_BAR), F.MISC + 8);
#ifndef PH_MASK
#define PH_MASK 0xffffffffu
#endif
#define IN(k) (lo <= (k) && (k) < hi && ((PH_MASK >> (((k) < 2) ? (k) : (k) == N_PHASES - 1 ? 7 : 2 + ((k) - 2) % 5)) & 1u))
#define SEAM(k) do { if (IN(k) && IN((k) + 1)) xcd_barrier(bar); } while (0)
    unsigned char* ws = uni(args.ws); F.ws = ws; F.out = uni(args.out); F.ctl = (gu32*)(ws + WS_CTL);
    float* mod = (float*)(ws + WS_CTL + CTL_MOD); float* ssq = (float*)(ws + WS_CTL + CTL_SUMSQ);
    if (IN(0)) { p0a(F); } SEAM(0);
    if (IN(1)) { p0b(F); } SEAM(1);
#pragma unroll 1
    for (int l = 0; l < DEPTH; ++l) {
        const int pb = 2 + 5 * l;
        unsigned char* wl = ws + WS_W + l * W_LAYER;
        const float* ml = mod + (size_t)l * 3 * 6144;
        if (IN(pb)) {
            cache_rows(F, l);
            pg8::Gemm g{(const pg8::bf16_t*)(ws + WS_H1), (const pg8::bf16_t*)(wl + W_IN_OFF), NTOK, DIN, DMODEL}; pg8::StaticOrder S; S.init(NTOK, DIN, F.G, (int)blockIdx.x);
            pg8::EpiIn E{l, l == 0 ? (const float*)(ws + WS_SS0) : ssq + (size_t)NTOK, (const float*)(ws + WS_CTL + CTL_CIN) + (size_t)l * 3 * DIN, F.in[15] + l * 64, F.in[16] + l * 64,
                         (const float*)(ws + WS_ROPE), (pg8::bf16_t*)(ws + WS_QO), (pg8::bf16_t*)(ws + WS_KV), F.out};
            pg8::gemm_phase<pg8::EpiIn, pg8::StaticOrder, true, true>(F.lds + RING_OFF, g, S, E);
        } SEAM(pb);
        if (IN(pb + 1)) { attn_phase(F, l); } SEAM(pb + 1);
        if (IN(pb + 2)) {
            pg8::Gemm g{(const pg8::bf16_t*)(ws + WS_QO), (const pg8::bf16_t*)(wl + W_OUT_OFF), NTOK, DMODEL, DMODEL}; pg8::StaticOrder S; S.init(NTOK, DMODEL, F.G, (int)blockIdx.x);
            pg8::EpiRes E{l == 0 ? F.in[0] : F.out, l == 0 ? F.in[1] : F.out + (size_t)NPROMPT * DMODEL, F.out, ml + 2048, F.in[13] + l * DMODEL, ml + 4096,
                          (pg8::bf16_t*)(ws + WS_H2), ssq + (size_t)(l == 0 ? 0 : 2) * NTOK};
            pg8::gemm_phase<pg8::EpiRes, pg8::StaticOrder, true, true>(F.lds + RING_OFF, g, S, E);
        } SEAM(pb + 2);
        if (IN(pb + 3)) {
            pg8::Gemm g{(const pg8::bf16_t*)(ws + WS_H2), (const pg8::bf16_t*)(wl + W_UP_OFF), NTOK, DUP, DMODEL}; pg8::StaticOrder S; S.init(NTOK, DUP, F.G, (int)blockIdx.x);
            pg8::EpiUpConv E{ssq + (size_t)(l == 0 ? 0 : 2) * NTOK, (const float*)(ws + WS_CTL + CTL_CUP) + (size_t)l * 3 * DUP, F.in[25] + (size_t)l * 3 * DUP, F.in[26] + (size_t)l * DUP,
                             (pg8::bf16_t*)(ws + WS_ACT), (float*)(ws + WS_HALO)};
            pg8::gemm_phase<pg8::EpiUpConv, pg8::StaticOrder, true, true>(F.lds + RING_OFF, g, S, E);
        } SEAM(pb + 3);
        if (IN(pb + 4)) {
            pg8::Gemm g{(const pg8::bf16_t*)(ws + WS_ACT), (const pg8::bf16_t*)(wl + W_DOWN_OFF), NTOK, DMODEL, DFF}; pg8::StaticOrder S; S.init(NTOK, DMODEL, F.G, (int)blockIdx.x);
            relane(F);
            { pg8::Unit uu; for (int i = 0; S.next(i, uu); ++i) conv_fixup(F, l, uu.pm); }
            asm volatile("s_waitcnt vmcnt(0)" ::: "memory"); __syncthreads();
            const bool more = (l + 1 < DEPTH);
            pg8::EpiRes E{F.out, F.out + (size_t)NPROMPT * DMODEL, F.out, ml + 5120, more ? F.in[12] + (l + 1) * DMODEL : nullptr, more ? ml + 3 * 6144 + 1024 : nullptr,
                          more ? (pg8::bf16_t*)(ws + WS_H1) : nullptr, ssq + (size_t)(l == 0 ? 1 : 3) * NTOK};
            pg8::gemm_phase<pg8::EpiRes, pg8::StaticOrder, true, true>(F.lds + RING_OFF, g, S, E);
        } SEAM(pb + 4);
    }
    if (IN(N_PHASES - 1)) final_phase(F);
#undef IN
#undef SEAM
}

extern "C" void kernel_launch(void* const* d_in, const int* in_sizes, int n_in, void* d_out, int out_size, void* d_ws, size_t ws_size, hipStream_t stream) {
    static int grid = 0;
    if (grid == 0) {
        if (n_in != 29 || out_size != (int)pg8::O_TOTAL || ws_size < WS_END) { fprintf(stderr, "kernel_launch: unexpected shapes (n_in %d, out %d, ws %zu); nothing launched\n", n_in, out_size, ws_size); grid = -1; return; }
        int dev = 0, cus = 0, per_cu = 0;
        if (hipGetDevice(&dev) != hipSuccess || hipDeviceGetAttribute(&cus, hipDeviceAttributeMultiprocessorCount, dev) != hipSuccess) { grid = -1; return; }
        if (hipFuncSetAttribute((const void*)fwd_kernel, hipFuncAttributeMaxDynamicSharedMemorySize, LDS_BYTES) != hipSuccess) { fprintf(stderr, "kernel_launch: hipFuncSetAttribute failed\n"); grid = -1; return; }
        if (hipOccupancyMaxActiveBlocksPerMultiprocessor(&per_cu, (const void*)fwd_kernel, NWAVES * 64, LDS_BYTES) != hipSuccess || per_cu < 1) { fprintf(stderr, "kernel_launch: occupancy query reports %d blocks per CU\n", per_cu); }
        (void)hipGetLastError();
        grid = cus;
    }
    if (grid < 0) return;
    if (hipMemsetAsync((char*)d_ws + WS_CTL, 0, CTL_ZERO_BYTES, stream) != hipSuccess) return;
    Args a{};
    for (int i = 0; i < 29; ++i) a.in[i] = (const float*)d_in[i];
    a.out = (float*)d_out; a.ws = (unsigned char*)d_ws;
    if (MK_N_LAUNCHES == 1) { a.ph_lo = 0; a.ph_hi = N_PHASES; hipLaunchKernelGGL(fwd_kernel, dim3(grid), dim3(NWAVES * 64), LDS_BYTES, stream, a); }
    else for (int p = 0; p < N_PHASES; ++p) { a.ph_lo = p; a.ph_hi = p + 1; hipLaunchKernelGGL(fwd_kernel, dim3(grid), dim3(NWAVES * 64), LDS_BYTES, stream, a); }
}
```
